# Optimizing an MI355X kernel written in HIP

```python
import math
import jax, jax.numpy as jnp
from jax import lax
import numpy as np

D_MODEL = 1024
BATCH = 8
SEQ = 8192
DEPTH = 4

N_MIXERS = 3
D_FF = 2816
CONV_WIDTH = 3
POOL_WINDOWS = (2, 4, 8, 16)
POOL_GROUPS = len(POOL_WINDOWS)
POOL_CH = D_MODEL // POOL_GROUPS
HEAD_DIM = 64
N_HEADS = D_MODEL // HEAD_DIM
N_KV_HEADS = 2
GQA_GROUP = N_HEADS // N_KV_HEADS
WINDOW = 128
BLOCK = 128
NUM_BUCKETS = 32
MAX_EXACT = NUM_BUCKETS // 2
MAX_DISTANCE = 128
EPS = 1e-6

N_A = (DEPTH + 2) // 3
N_B = (DEPTH + 1) // 3
N_C = DEPTH // 3

kernel_name = "interleaved_hybrid_conv_pool_swa_macaron"


def rmsnorm(x, g):
    xf = x.astype(jnp.float32)
    xf = xf * lax.rsqrt(jnp.mean(xf * xf, axis=-1, keepdims=True) + EPS)
    return (xf * g.astype(jnp.float32)).astype(x.dtype)


def swiglu(h, w_in, w_out):
    gate, up = jnp.split(h @ w_in, 2, axis=-1)
    return (jax.nn.silu(gate) * up) @ w_out


def short_conv_mixer(h, w_in, conv_w, w_out):
    b, c, v = jnp.split(h @ w_in, 3, axis=-1)
    z = c * v
    zp = jnp.pad(z, ((0, 0), (CONV_WIDTH - 1, 0), (0, 0)))
    s = z.shape[1]
    conv = conv_w[0] * zp[:, 0:s] + conv_w[1] * zp[:, 1:s + 1] + conv_w[2] * zp[:, 2:s + 2]
    return (b * conv) @ w_out


def multiscale_pool_mixer(h, w, bias, scale):
    bsz, s, d = h.shape
    hf = h.astype(jnp.float32).reshape(bsz, s, POOL_GROUPS, POOL_CH)
    cs = jnp.cumsum(hf, axis=1)
    t = jnp.arange(s)
    outs = []
    for g, win in enumerate(POOL_WINDOWS):
        c = cs[:, :, g]
        lower = jnp.pad(c, ((0, 0), (win, 0), (0, 0)))[:, :s]
        cnt = jnp.minimum(t + 1, win).astype(jnp.float32)[None, :, None]
        outs.append((c - lower) / cnt - hf[:, :, g])
    diff = jnp.stack(outs, axis=2).astype(h.dtype)
    y = jnp.einsum('bsgc,gcd->bsgd', diff, w).reshape(bsz, s, d) + bias
    return y * scale


def t5_causal_buckets(n):
    nf = np.maximum(n, 1).astype(np.float32)
    large = MAX_EXACT + (np.log(nf / MAX_EXACT) / math.log(MAX_DISTANCE / MAX_EXACT)
                         * (NUM_BUCKETS - MAX_EXACT)).astype(np.int32)
    large = np.minimum(large, NUM_BUCKETS - 1)
    return np.where(n < MAX_EXACT, n, large).astype(np.int32)


def head_rms(x, g):
    xf = x.astype(jnp.float32)
    xf = xf * lax.rsqrt(jnp.mean(xf * xf, axis=-1, keepdims=True) + EPS)
    return (xf * g.astype(jnp.float32)).astype(x.dtype)


def swa_attention_mixer(h, w_qkv, b_qkv, q_gain, k_gain, sinks, w_o, b_o, rel_bias):
    bsz, s, _ = h.shape
    nblk = s // BLOCK
    qkv = h @ w_qkv + b_qkv
    q, k, v = jnp.split(qkv, [N_HEADS * HEAD_DIM, (N_HEADS + N_KV_HEADS) * HEAD_DIM], axis=-1)
    q = head_rms(q.reshape(bsz, s, N_KV_HEADS, GQA_GROUP, HEAD_DIM), q_gain)
    k = head_rms(k.reshape(bsz, s, N_KV_HEADS, HEAD_DIM), k_gain)
    v = v.reshape(bsz, s, N_KV_HEADS, HEAD_DIM)

    q = q.reshape(bsz, nblk, BLOCK, N_KV_HEADS, GQA_GROUP, HEAD_DIM)

    def band(t):
        tb = t.reshape(bsz, nblk, BLOCK, N_KV_HEADS, HEAD_DIM)
        prev = jnp.concatenate([jnp.zeros_like(tb[:, :1]), tb[:, :-1]], axis=1)
        return jnp.concatenate([prev, tb], axis=2)

    kw, vw = band(k), band(v)
    scores = jnp.einsum('bnqhgd,bnkhd->bnhgqk', q, kw).astype(jnp.float32) * (HEAD_DIM ** -0.5)

    qi = np.arange(BLOCK)[:, None]
    ki = np.arange(2 * BLOCK)[None, :]
    dist = qi + BLOCK - ki
    buckets = t5_causal_buckets(dist)
    bias = rel_bias.astype(jnp.float32)[buckets]
    bias = jnp.transpose(bias, (2, 0, 1)).reshape(N_KV_HEADS, GQA_GROUP, BLOCK, 2 * BLOCK)
    scores = scores + bias[None, None]

    in_band = (dist >= 0) & (dist < WINDOW)
    key_pos = jnp.arange(nblk)[:, None, None] * BLOCK - BLOCK + jnp.asarray(ki)[None]
    mask = jnp.asarray(in_band)[None] & (key_pos >= 0)
    scores = jnp.where(mask[None, :, None, None], scores, -jnp.inf)

    sink = sinks.astype(jnp.float32).reshape(N_KV_HEADS, GQA_GROUP)[None, None, :, :, None, None]
    m = jnp.maximum(jnp.max(scores, axis=-1, keepdims=True), sink)
    p = jnp.exp(scores - m)
    denom = jnp.sum(p, axis=-1, keepdims=True) + jnp.exp(sink - m)
    probs = (p / denom).astype(vw.dtype)
    o = jnp.einsum('bnhgqk,bnkhd->bnqhgd', probs, vw).reshape(bsz, s, N_HEADS * HEAD_DIM)
    return o @ w_o + b_o


def setup_inputs(seed: int = 0) -> dict:
    key = jax.random.key(seed)
    ks = iter(jax.random.split(key, 32))

    def nrm(shape, scale):
        return jax.random.normal(next(ks), shape, jnp.float32) * scale

    def gain(shape):
        return 1.0 + nrm(shape, 0.1)

    qkv_w = (N_HEADS + 2 * N_KV_HEADS) * HEAD_DIM
    return {
        "x": nrm((BATCH, SEQ, D_MODEL), 1.0),
        "ffn1_norm": gain((DEPTH, D_MODEL)),
        "ffn1_w_in": nrm((DEPTH, D_MODEL, 2 * D_FF), D_MODEL ** -0.5),
        "ffn1_w_out": nrm((DEPTH, D_FF, D_MODEL), D_FF ** -0.5),
        "mix_norm": gain((DEPTH, D_MODEL)),
        "ffn2_norm": gain((DEPTH, D_MODEL)),
        "ffn2_w_in": nrm((DEPTH, D_MODEL, 2 * D_FF), D_MODEL ** -0.5),
        "ffn2_w_out": nrm((DEPTH, D_FF, D_MODEL), D_FF ** -0.5),
        "conv_w_in": nrm((N_A, D_MODEL, 3 * D_MODEL), D_MODEL ** -0.5),
        "conv_w": nrm((N_A, CONV_WIDTH, D_MODEL), CONV_WIDTH ** -0.5),
        "conv_w_out": nrm((N_A, D_MODEL, D_MODEL), D_MODEL ** -0.5),
        "pool_w": nrm((N_B, POOL_GROUPS, POOL_CH, POOL_CH), POOL_CH ** -0.5),
        "pool_b": nrm((N_B, D_MODEL), 0.02),
        "pool_scale": 0.5 + nrm((N_B, D_MODEL), 0.05),
        "attn_w_qkv": nrm((N_C, D_MODEL, qkv_w), D_MODEL ** -0.5),
        "attn_b_qkv": nrm((N_C, qkv_w), 0.02),
        "attn_q_norm": gain((N_C, HEAD_DIM)),
        "attn_k_norm": gain((N_C, HEAD_DIM)),
        "attn_sinks": nrm((N_C, N_HEADS), 0.5),
        "attn_w_o": nrm((N_C, N_HEADS * HEAD_DIM, D_MODEL), (N_HEADS * HEAD_DIM) ** -0.5),
        "attn_b_o": nrm((N_C, D_MODEL), 0.02),
        "rel_bias": nrm((NUM_BUCKETS, N_HEADS), 0.5),
    }


def reference(x, ffn1_norm, ffn1_w_in, ffn1_w_out, mix_norm, ffn2_norm, ffn2_w_in, ffn2_w_out,
              conv_w_in, conv_w, conv_w_out, pool_w, pool_b, pool_scale,
              attn_w_qkv, attn_b_qkv, attn_q_norm, attn_k_norm, attn_sinks, attn_w_o, attn_b_o,
              rel_bias):
    for i in range(DEPTH):
        x = x + 0.5 * swiglu(rmsnorm(x, ffn1_norm[i]), ffn1_w_in[i], ffn1_w_out[i])
        h = rmsnorm(x, mix_norm[i])
        kind, j = i % N_MIXERS, i // N_MIXERS
        if kind == 0:
            y = short_conv_mixer(h, conv_w_in[j], conv_w[j], conv_w_out[j])
        elif kind == 1:
            y = multiscale_pool_mixer(h, pool_w[j], pool_b[j], pool_scale[j])
        else:
            y = swa_attention_mixer(h, attn_w_qkv[j], attn_b_qkv[j], attn_q_norm[j], attn_k_norm[j],
                                    attn_sinks[j], attn_w_o[j], attn_b_o[j], rel_bias)
        x = x + y
        x = x + 0.5 * swiglu(rmsnorm(x, ffn2_norm[i]), ffn2_w_in[i], ffn2_w_out[i])
    return x
```

```cpp
#include <hip/hip_runtime.h>
#include <hip/hip_cooperative_groups.h>
#include <cstdio>
#include <cstdint>
namespace cg = cooperative_groups;

#ifndef MK_ONE_LAUNCH
#define MK_ONE_LAUNCH 1
#endif

#define LAS __attribute__((address_space(3)))
typedef unsigned short bf16_t;
typedef short bf16x8 __attribute__((ext_vector_type(8)));
typedef short s16x4 __attribute__((ext_vector_type(4)));
typedef float f32x4 __attribute__((ext_vector_type(4)));
typedef float f32x16 __attribute__((ext_vector_type(16)));
typedef unsigned u32x4 __attribute__((ext_vector_type(4)));
typedef unsigned u32x2 __attribute__((ext_vector_type(2)));
typedef float f32x2_t __attribute__((ext_vector_type(2)));
typedef __bf16 bf16x2_t __attribute__((ext_vector_type(2)));

constexpr int D = 1024, BATCH = 8, SEQ = 8192, M = BATCH * SEQ, DEPTH = 4, FF = 2816, NQKV = 1280;
constexpr float EPS = 1e-6f;

__device__ __forceinline__ unsigned cvtpk(float lo, float hi) { f32x2_t v = {lo, hi}; bf16x2_t b = __builtin_convertvector(v, bf16x2_t); return __builtin_bit_cast(unsigned, b); }
__device__ __forceinline__ size_t xt_off(int row, int col) { return ((size_t)(row >> 4) * 32 + (col >> 5)) * 512 + (row & 15) * 32 + (col & 31); }
__device__ __forceinline__ float bf_lo(unsigned u) { return __uint_as_float(u << 16); }
__device__ __forceinline__ float bf_hi(unsigned u) { return __uint_as_float(u & 0xffff0000u); }

namespace pg8 {
constexpr int BM = 256, BK = 64, HALF = 128, HTB = HALF * BK * 2, STAGE_BYTES = 8 * HTB, NXCD = 8, WGM = 8;
constexpr int EPI_STG_OFF = 131072 + 2048, EPI_STG_BYTES = 16 * 144;
__host__ __device__ __forceinline__ int lds_byte(int r, int c) { const int st = (r >> 4) * 2 + (c >> 5), rr = r & 15, cc = c & 31, ob = rr * 64 + cc * 2; return st * 1024 + (ob ^ (((ob >> 9) & 1) << 5)); }
__host__ __device__ __forceinline__ void stage_rc(int b, int& R, int& C) { const int st = b / 1024, sb = b % 1024, swz = sb ^ (((sb >> 9) & 1) << 5); R = (st >> 1) * 16 + swz / 64; C = (st & 1) * 32 + (swz % 64) / 2; }
__host__ __device__ __forceinline__ int perm32(int rho) { const int n = rho >> 4, i = rho & 15; return 8 * (i >> 2) + 4 * n + (i & 3); }

struct Unit { int pm, pn; };
struct Gemm { const bf16_t* A; const bf16_t* Bt; int M, N, K, lda, a_pn_off, a_tiled; };

struct StaticOrder {
    int nM, nN, nwg, G, c;
    __host__ __device__ void init(int M_, int N_, int G_, int c_) { nM = M_ / BM; nN = N_ / BM; nwg = nM * nN; G = G_; c = c_; }
    __host__ __device__ bool next(int i, Unit& u) const {
        const long L = (long)i * G + c; if (L >= nwg) return false;
        int wgid = (int)L; { const int q = nwg / NXCD, r = nwg % NXCD, xcd = wgid % NXCD, off = wgid / NXCD; wgid = (xcd < r ? xcd * (q + 1) : r * (q + 1) + (xcd - r) * q) + off; }
        const int nig = WGM * nN, gid = wgid / nig, fm = gid * WGM, gsz = (nM - fm) < WGM ? (nM - fm) : WGM;
        u.pm = fm + ((wgid % nig) % gsz); u.pn = (wgid % nig) / gsz; return true;
    }
};

typedef f32x4 AccT[2][2][4][2];

__device__ __forceinline__ f32x4 gload16(const void* p) { f32x4 v; asm volatile("global_load_dwordx4 %0, %1, off" : "=v"(v) : "v"(p) : "memory"); return v; }
__device__ __forceinline__ f32x4 gload16_nt(const void* p) { f32x4 v; asm volatile("global_load_dwordx4 %0, %1, off nt" : "=v"(v) : "v"(p) : "memory"); return v; }
#define WAIT8(a) asm volatile("s_waitcnt vmcnt(0)" : "+v"(a[0]), "+v"(a[1]), "+v"(a[2]), "+v"(a[3]), "+v"(a[4]), "+v"(a[5]), "+v"(a[6]), "+v"(a[7]) :: "memory")
#define WAIT16(a) asm volatile("s_waitcnt vmcnt(0)" : "+v"(a[0]), "+v"(a[1]), "+v"(a[2]), "+v"(a[3]), "+v"(a[4]), "+v"(a[5]), "+v"(a[6]), "+v"(a[7]), "+v"(a[8]), "+v"(a[9]), "+v"(a[10]), "+v"(a[11]), "+v"(a[12]), "+v"(a[13]), "+v"(a[14]), "+v"(a[15]) :: "memory")
__device__ __forceinline__ float row_rstd(const float* SS, int row) {
    const f32x4* p = (const f32x4*)(SS + (size_t)row * 16);
    const f32x4 a = p[0], b = p[1], c = p[2], d = p[3];
    const f32x4 s = (a + b) + (c + d);
    return 1.0f / sqrtf(((s.x + s.y) + (s.z + s.w)) * (1.f / D) + EPS);
}
__device__ __forceinline__ void rows_rstd(const float* SS, int row0, int fq, float (&rs)[2][4]) {
    f32x4 p[8];
#pragma unroll
    for (int i = 0; i < 8; ++i) p[i] = gload16(SS + (size_t)(row0 + (i >> 2) * HALF + (i & 3) * 16) * 16 + fq * 4);
    WAIT8(p);
#pragma unroll
    for (int i = 0; i < 8; ++i) {
        float s = (p[i].x + p[i].y) + (p[i].z + p[i].w);
        s += __shfl_xor(s, 16); s += __shfl_xor(s, 32);
        rs[i >> 2][i & 3] = __builtin_amdgcn_rsqf(s * (1.f / D) + EPS);
    }
}
__device__ __forceinline__ void rows_rstd_issue(const float* SS, int row0, int fq, f32x4 (&p)[8]) {
#pragma unroll
    for (int i = 0; i < 8; ++i) p[i] = gload16(SS + (size_t)(row0 + (i >> 2) * HALF + (i & 3) * 16) * 16 + fq * 4);
}
__device__ __forceinline__ void rows_rstd_finish(f32x4 (&p)[8], float (&rs)[2][4]) {
    WAIT8(p);
#pragma unroll
    for (int i = 0; i < 8; ++i) {
        float s = (p[i].x + p[i].y) + (p[i].z + p[i].w);
        s += __shfl_xor(s, 16); s += __shfl_xor(s, 32);
        rs[i >> 2][i & 3] = __builtin_amdgcn_rsqf(s * (1.f / D) + EPS);
    }
}
struct EpiSwiglu {
    static constexpr bool WIDE = false, NEXT_RS = false;
    bf16_t* O; int ldo; const float* SS;
    __device__ __forceinline__ void operator()(const AccT& acc, const Unit& u, int wr, int wc, int fr, int fq, LAS unsigned char* stg) const {
        const int row0 = u.pm * BM + wr * 64 + fr;
        float rs[2][4];
        rows_rstd(SS, row0, fq, rs);
#pragma unroll
        for (int ai = 0; ai < 2; ++ai)
#pragma unroll
            for (int m = 0; m < 4; ++m) {
                bf16_t* rowp = O + ((size_t)(u.pm * 16 + wr * 4 + ai * 8 + m) * (ldo >> 5) + (u.pn * 4 + wc)) * 512 + fr * 32 + 8 * fq;
                const float k1 = rs[ai][m] * -1.4426950408889634f, k2 = rs[ai][m] * rs[ai][m];
                float r[8];
#pragma unroll
                for (int n = 0; n < 2; ++n)
#pragma unroll
                    for (int i = 0; i < 4; ++i) {
                        const float g = acc[ai][0][m][n][i], up = acc[ai][1][m][n][i];
                        const float e = __builtin_amdgcn_exp2f(g * k1);
                        r[n * 4 + i] = (g * up) * (k2 * __builtin_amdgcn_rcpf(1.0f + e));
                    }
                u32x4 w; w.x = cvtpk(r[0], r[1]); w.y = cvtpk(r[2], r[3]); w.z = cvtpk(r[4], r[5]); w.w = cvtpk(r[6], r[7]);
                __builtin_nontemporal_store(w, (u32x4*)rowp);
            }
    }
};
template <bool LAST> struct EpiResid {
    static constexpr bool WIDE = true, NEXT_RS = false;
    float* fout; bf16_t* XB; bf16_t* XL; float* SS;
    __device__ __forceinline__ void operator()(const AccT& acc, const Unit& u, int wr, int wc, int fr, int fq, LAS unsigned char* stg) const {
        const int row0 = u.pm * BM + wr * 64 + fr, col0 = u.pn * BM + wc * 64 + 8 * fq;
        const size_t blk0 = ((size_t)(u.pm * 16 + wr * 4) * 32 + (u.pn * 8 + wc * 2)) * 512 + fr * 32 + 8 * fq;
        constexpr bool last = LAST;
#pragma unroll
        for (int ai = 0; ai < 2; ++ai) {
            f32x4 pre[16];
#pragma unroll
            for (int m = 0; m < 4; ++m) {
                const size_t boff = blk0 + (size_t)(ai * 8 + m) * (32 * 512);
                pre[m * 4 + 0] = gload16_nt(XB + boff); pre[m * 4 + 1] = gload16_nt(XB + boff + 512); pre[m * 4 + 2] = gload16_nt(XL + boff); pre[m * 4 + 3] = gload16_nt(XL + boff + 512);
            }
            WAIT16(pre);
#pragma unroll
            for (int m = 0; m < 4; ++m) {
                const size_t boff = blk0 + (size_t)(ai * 8 + m) * (32 * 512);
                const size_t off = (size_t)(row0 + ai * HALF + m * 16) * D + col0;
                float ssq = 0.f;
#pragma unroll
                for (int bj = 0; bj < 2; ++bj) {
                    const u32x4 hi = __builtin_bit_cast(u32x4, pre[m * 4 + bj]), lo = __builtin_bit_cast(u32x4, pre[m * 4 + 2 + bj]);
                    f32x4 o0, o1;
                    o0.x = bf_lo(hi.x) + bf_lo(lo.x); o0.y = bf_hi(hi.x) + bf_hi(lo.x); o0.z = bf_lo(hi.y) + bf_lo(lo.y); o0.w = bf_hi(hi.y) + bf_hi(lo.y);
                    o1.x = bf_lo(hi.z) + bf_lo(lo.z); o1.y = bf_hi(hi.z) + bf_hi(lo.z); o1.z = bf_lo(hi.w) + bf_lo(lo.w); o1.w = bf_hi(hi.w) + bf_hi(lo.w);
                    o0 += acc[ai][bj][m][0]; o1 += acc[ai][bj][m][1];
                    if constexpr (last) { *(f32x4*)(fout + off + bj * 32) = o0; *(f32x4*)(fout + off + bj * 32 + 4) = o1; }
                    else {
                        ssq += (o0.x * o0.x + o0.y * o0.y) + (o0.z * o0.z + o0.w * o0.w) + (o1.x * o1.x + o1.y * o1.y) + (o1.z * o1.z + o1.w * o1.w);
                        u32x4 w; w.x = cvtpk(o0.x, o0.y); w.y = cvtpk(o0.z, o0.w); w.z = cvtpk(o1.x, o1.y); w.w = cvtpk(o1.z, o1.w);
                        *(u32x4*)(XB + boff + bj * 512) = w;
                        u32x4 l;
                        l.x = cvtpk(o0.x - bf_lo(w.x), o0.y - bf_hi(w.x)); l.y = cvtpk(o0.z - bf_lo(w.y), o0.w - bf_hi(w.y));
                        l.z = cvtpk(o1.x - bf_lo(w.z), o1.y - bf_hi(w.z)); l.w = cvtpk(o1.z - bf_lo(w.w), o1.w - bf_hi(w.w));
                        __builtin_nontemporal_store(l, (u32x4*)(XL + boff + bj * 512));
                    }
                }
                if constexpr (!last) {
                    ssq += __shfl_xor(ssq, 16); ssq += __shfl_xor(ssq, 32);
                    if (fq == 0) SS[(size_t)(row0 + ai * HALF + m * 16) * 16 + u.pn * 4 + wc] = ssq;
                }
            }
        }
    }
};
struct EpiBf16 {
    static constexpr bool WIDE = false, NEXT_RS = false;
    bf16_t* O; int ldo; const float* bias; const float* SS;
    __device__ __forceinline__ void operator()(const AccT& acc, const Unit& u, int wr, int wc, int fr, int fq, LAS unsigned char* stg) const {
        const int row0 = u.pm * BM + wr * 64 + fr, col0 = u.pn * BM + wc * 32 + 8 * fq;
        f32x4 bv[2][2];
#pragma unroll
        for (int bj = 0; bj < 2; ++bj)
#pragma unroll
            for (int n = 0; n < 2; ++n) bv[bj][n] = *(const f32x4*)(bias + col0 + bj * HALF + 4 * n);
        float rsv[2][4];
        rows_rstd(SS, row0, fq, rsv);
#pragma unroll
        for (int ai = 0; ai < 2; ++ai)
#pragma unroll
            for (int m = 0; m < 4; ++m) {
                bf16_t* rowp = O + (size_t)(row0 + ai * HALF + m * 16) * ldo + col0;
                const float rs = rsv[ai][m];
#pragma unroll
                for (int bj = 0; bj < 2; ++bj) {
                    const f32x4 v0 = acc[ai][bj][m][0] * rs + bv[bj][0], v1 = acc[ai][bj][m][1] * rs + bv[bj][1];
                    u32x4 w; w.x = cvtpk(v0[0], v0[1]); w.y = cvtpk(v0[2], v0[3]); w.z = cvtpk(v1[0], v1[1]); w.w = cvtpk(v1[2], v1[3]);
                    *(u32x4*)(rowp + bj * HALF) = w;
                }
            }
    }
};
struct EpiConvIn {
    static constexpr bool WIDE = false, NEXT_RS = false;
    bf16_t* Bb; bf16_t* Z; const float* SS;
    __device__ __forceinline__ void operator()(const AccT& acc, const Unit& u, int wr, int wc, int fr, int fq, LAS unsigned char* stg) const {
        const int row0 = u.pm * BM + wr * 64 + fr;
        float rsv[2][4];
        rows_rstd(SS, row0, fq, rsv);
        if (u.pn < 4) {
            const int col0 = u.pn * BM + wc * 32 + 8 * fq;
#pragma unroll
            for (int ai = 0; ai < 2; ++ai)
#pragma unroll
                for (int m = 0; m < 4; ++m) {
                    bf16_t* rowp = Bb + (size_t)(row0 + ai * HALF + m * 16) * D + col0;
                    const float rs = rsv[ai][m];
#pragma unroll
                    for (int bj = 0; bj < 2; ++bj) {
                        const f32x4 v0 = acc[ai][bj][m][0] * rs, v1 = acc[ai][bj][m][1] * rs;
                        u32x4 w; w.x = cvtpk(v0[0], v0[1]); w.y = cvtpk(v0[2], v0[3]); w.z = cvtpk(v1[0], v1[1]); w.w = cvtpk(v1[2], v1[3]);
                        *(u32x4*)(rowp + bj * HALF) = w;
                    }
                }
        } else {
            const int col0 = (u.pn - 4) * HALF + wc * 32 + 8 * fq;
#pragma unroll
            for (int ai = 0; ai < 2; ++ai)
#pragma unroll
                for (int m = 0; m < 4; ++m) {
                    bf16_t* rowp = Z + (size_t)(row0 + ai * HALF + m * 16) * D + col0;
                    const float rs = rsv[ai][m], rs2 = rs * rs;
                    const f32x4 v0 = acc[ai][0][m][0] * acc[ai][1][m][0] * rs2, v1 = acc[ai][0][m][1] * acc[ai][1][m][1] * rs2;
                    u32x4 w; w.x = cvtpk(v0[0], v0[1]); w.y = cvtpk(v0[2], v0[3]); w.z = cvtpk(v1[0], v1[1]); w.w = cvtpk(v1[2], v1[3]);
                    *(u32x4*)rowp = w;
                }
        }
    }
};

template <class Epi>
__device__ __forceinline__ void gemm_phase(LAS unsigned char* lds, const Gemm g, const StaticOrder& S, const Epi& E, const int tid) {
    const int wid = __builtin_amdgcn_readfirstlane(tid >> 6), lane = tid & 63, wr = wid >> 2, wc = wid & 3, fr = lane & 15, fq = lane >> 4;
    const int K = g.K, nt = K / BK, lda = g.lda;
    unsigned voffA[2], voffB[2];
#pragma unroll
    for (int i = 0; i < 2; ++i) { int R, C; stage_rc(tid * 16 + i * 8192, R, C); const int Rb = Epi::WIDE ? (64 * (R >> 5) + perm32(R & 31)) : ((R & ~31) + perm32(R & 31));
        voffA[i] = g.a_tiled ? (unsigned)(((R >> 4) * (lda >> 5) + (C >> 5)) * 512 + (R & 15) * 32 + (C & 31)) * 2u : (unsigned)(R * lda + C) * 2u; voffB[i] = (unsigned)(Rb * K + C) * 2u; }
    const size_t kstep = (size_t)(BK * 2), kstepA = g.a_tiled ? (size_t)2048 : kstep;
    const size_t hstepA = (size_t)HALF * lda * 2, tstepA = 2 * hstepA;
    const size_t hstepB = (size_t)(Epi::WIDE ? 32 : HALF) * K * 2, tstepB = (size_t)BM * K * 2;
    const size_t pnoffA = (size_t)g.a_pn_off * 2;
    const unsigned ldsw = (unsigned)wid * 1024u;
    const int aoff = lds_byte(wr * 64 + fr, fq * 8), boff = lds_byte(wc * 32 + fr, fq * 8);
#define PG8_SA(b, h) (((b) * 2 + (h)) * HTB)
#define PG8_SB(b, h) ((4 + (b) * 2 + (h)) * HTB)
#define PG8_STAGE(bufoff, gbase, voff) do { _Pragma("unroll") for (int _i = 0; _i < 2; ++_i) \
        __builtin_amdgcn_global_load_lds((const unsigned*)((const char*)(gbase) + (voff)[_i]), (LAS unsigned*)(lds + (bufoff) + ldsw + _i * 8192), 16, 0, 0); } while (0)
#define PG8_LDA(dst, b, h) do { _Pragma("unroll") for (int m = 0; m < 4; ++m) _Pragma("unroll") for (int k = 0; k < 2; ++k) dst[m][k] = *(const LAS bf16x8*)(lds + PG8_SA(b, h) + aoff + m * 2048 + k * 1024); } while (0)
#define PG8_LDB(dst, b, h) do { _Pragma("unroll") for (int n = 0; n < 2; ++n) _Pragma("unroll") for (int k = 0; k < 2; ++k) dst[n][k] = *(const LAS bf16x8*)(lds + PG8_SB(b, h) + boff + n * 2048 + k * 1024); } while (0)
#define PG8_MMA(ai, bj, At, Bt) do { __builtin_amdgcn_s_setprio(1); _Pragma("unroll") for (int m = 0; m < 4; ++m) _Pragma("unroll") for (int n = 0; n < 2; ++n) _Pragma("unroll") for (int k = 0; k < 2; ++k) \
        acc[ai][bj][m][n] = __builtin_amdgcn_mfma_f32_16x16x32_bf16(Bt[n][k], At[m][k], acc[ai][bj][m][n], 0, 0, 0); __builtin_amdgcn_s_setprio(0); } while (0)
#define PG8_WAIT_V(n) asm volatile("s_waitcnt vmcnt(" #n ")" ::: "memory")
#define PG8_WAIT_L(n) asm volatile("s_waitcnt lgkmcnt(" #n ")" ::: "memory")
#define PG8_BAR __builtin_amdgcn_s_barrier()
#define PG8_SCHED __builtin_amdgcn_sched_barrier(0)
    Unit cur, nxt; int ui = 0;
    if (!S.next(0, cur)) return;
    float rs[2][4];
    if constexpr (Epi::NEXT_RS) rows_rstd(E.SS, cur.pm * BM + wr * 64 + fr, fq, rs);
    f32x4 acc[2][2][4][2];
#pragma unroll
    for (int a = 0; a < 2; ++a)
#pragma unroll
        for (int b = 0; b < 2; ++b)
#pragma unroll
            for (int m = 0; m < 4; ++m)
#pragma unroll
                for (int n = 0; n < 2; ++n) acc[a][b][m][n] = (f32x4){0.f, 0.f, 0.f, 0.f};
    bf16x8 At[4][2], B0[2][2], B1[2][2];
    const char* cA = (const char*)g.A + (size_t)cur.pm * tstepA + (size_t)cur.pn * pnoffA; const char* cB = (const char*)g.Bt + (size_t)cur.pn * tstepB;
    PG8_STAGE(PG8_SB(0, 0), cB, voffB); PG8_STAGE(PG8_SB(0, 1), cB + hstepB, voffB); PG8_STAGE(PG8_SA(0, 0), cA, voffA); PG8_STAGE(PG8_SA(0, 1), cA + hstepA, voffA);
    if (wr == 1) PG8_BAR;
    PG8_WAIT_V(2); PG8_BAR;
    PG8_STAGE(PG8_SB(1, 0), cB + kstep, voffB); PG8_STAGE(PG8_SA(1, 0), cA + kstepA, voffA); PG8_STAGE(PG8_SB(1, 1), cB + hstepB + kstep, voffB);
    PG8_WAIT_V(6); PG8_BAR;
    for (;;) {
        const bool has_next = S.next(ui + 1, nxt);
        const char* nA = has_next ? (const char*)g.A + (size_t)nxt.pm * tstepA + (size_t)nxt.pn * pnoffA : cA; const char* nB = has_next ? (const char*)g.Bt + (size_t)nxt.pn * tstepB : cB;
        for (int t = 0; t < nt; t += 2) {
            const bool last = (t == nt - 2);
            const char* a1 = cA + (size_t)(t + 1) * kstepA;
            const char* a2 = last ? nA : cA + (size_t)(t + 2) * kstepA; const char* b2 = last ? nB : cB + (size_t)(t + 2) * kstep;
            const char* a3 = a2 + kstepA; const char* b3 = b2 + kstep;
            PG8_LDB(B0, 0, 0); PG8_LDB(B1, 0, 1); PG8_SCHED; PG8_LDA(At, 0, 0); PG8_STAGE(PG8_SA(1, 1), a1 + hstepA, voffA);
            PG8_WAIT_V(8); PG8_WAIT_L(0); PG8_BAR; PG8_MMA(0, 0, At, B0); PG8_MMA(0, 1, At, B1); PG8_BAR; PG8_SCHED;
            PG8_LDA(At, 0, 1); PG8_STAGE(PG8_SB(0, 0), b2, voffB); PG8_STAGE(PG8_SB(0, 1), b2 + hstepB, voffB); PG8_STAGE(PG8_SA(0, 0), a2, voffA);
            PG8_WAIT_V(8); PG8_WAIT_L(0); PG8_BAR; PG8_MMA(1, 0, At, B0); PG8_MMA(1, 1, At, B1); PG8_BAR; PG8_SCHED;
            PG8_LDB(B0, 1, 0); PG8_LDB(B1, 1, 1); PG8_SCHED; PG8_LDA(At, 1, 0); PG8_STAGE(PG8_SA(0, 1), a2 + hstepA, voffA);
            PG8_WAIT_V(8); PG8_WAIT_L(0); PG8_BAR; PG8_MMA(0, 0, At, B0); PG8_MMA(0, 1, At, B1); PG8_BAR; PG8_SCHED;
            PG8_LDA(At, 1, 1); PG8_STAGE(PG8_SB(1, 0), b3, voffB); PG8_STAGE(PG8_SB(1, 1), b3 + hstepB, voffB); PG8_STAGE(PG8_SA(1, 0), a3, voffA);
            PG8_WAIT_V(8); PG8_WAIT_L(0); PG8_BAR; PG8_MMA(1, 0, At, B0); PG8_MMA(1, 1, At, B1); PG8_BAR; PG8_SCHED;
        }
        if (wr == 0) PG8_BAR;
        if constexpr (Epi::NEXT_RS) E(acc, cur, wr, wc, fr, fq, lds + EPI_STG_OFF + wid * EPI_STG_BYTES, rs, has_next ? nxt.pm : cur.pm);
        else E(acc, cur, wr, wc, fr, fq, lds + EPI_STG_OFF + wid * EPI_STG_BYTES);
        if (!has_next) break;
#pragma unroll
        for (int a = 0; a < 2; ++a)
#pragma unroll
            for (int b = 0; b < 2; ++b)
#pragma unroll
                for (int m = 0; m < 4; ++m)
#pragma unroll
                    for (int n = 0; n < 2; ++n) acc[a][b][m][n] = (f32x4){0.f, 0.f, 0.f, 0.f};
        cur = nxt; cA = nA; cB = nB; ++ui;
        if (wr == 1) PG8_BAR;
    }
    PG8_WAIT_V(0);
    PG8_BAR;
#undef PG8_SA
#undef PG8_SB
#undef PG8_STAGE
#undef PG8_LDA
#undef PG8_LDB
#undef PG8_MMA
#undef PG8_WAIT_V
#undef PG8_WAIT_L
#undef PG8_BAR
#undef PG8_SCHED
}
}

constexpr size_t MiB = 1u << 20;
constexpr size_t WS_WIN = 2 * MiB;
constexpr size_t WS_WOUT = WS_WIN + 88 * MiB;
constexpr size_t WS_CIN = WS_WOUT + 44 * MiB;
constexpr size_t WS_COUT = WS_CIN + 12 * MiB;
constexpr size_t WS_POOL = WS_COUT + 4 * MiB;
constexpr size_t WS_WQKV = WS_POOL + 1 * MiB;
constexpr size_t WS_WO = WS_WQKV + 3 * MiB;
constexpr size_t WS_SS = 156 * MiB;
constexpr size_t WS_H = 160 * MiB;
constexpr size_t WS_ACT = 288 * MiB;
constexpr size_t WS_XL = 672 * MiB;
constexpr size_t WS_END = 800 * MiB;
constexpr size_t WS_ZEROS = 1 * MiB, WS_PBIAS = 1 * MiB + 4096;
constexpr size_t CTL_BYTES = 65536;
static_assert(WS_WO + 2 * MiB <= WS_SS, "ws map");
constexpr size_t WIN_STRIDE = (size_t)2 * FF * D;
constexpr size_t WOUT_STRIDE = (size_t)D * FF;

constexpr int RING_BYTES = 131072, LDS_BYTES = 155648;
static_assert(pg8::EPI_STG_OFF + 8 * pg8::EPI_STG_BYTES <= LDS_BYTES, "LDS map");

enum Op { OP_PROLOGUE = 0, OP_SWIGLU, OP_RESID_FFN, OP_CONV_IN, OP_CONV_EW, OP_CONV_OUT, OP_POOL_DIFF, OP_POOL_GEMM, OP_QKV, OP_ATTN, OP_WO };
constexpr int NSTEPS = 28;
__device__ const unsigned char PROG[NSTEPS][3] = {
    {OP_PROLOGUE, 0, 0},
    {OP_SWIGLU, 0, 0}, {OP_RESID_FFN, 0, 0}, {OP_CONV_IN, 0, 0}, {OP_CONV_EW, 0, 0}, {OP_CONV_OUT, 0, 0}, {OP_SWIGLU, 0, 1}, {OP_RESID_FFN, 0, 1},
    {OP_SWIGLU, 1, 0}, {OP_RESID_FFN, 1, 0}, {OP_POOL_DIFF, 1, 0}, {OP_POOL_GEMM, 1, 0}, {OP_SWIGLU, 1, 1}, {OP_RESID_FFN, 1, 1},
    {OP_SWIGLU, 2, 0}, {OP_RESID_FFN, 2, 0}, {OP_QKV, 2, 0}, {OP_ATTN, 2, 0}, {OP_WO, 2, 0}, {OP_SWIGLU, 2, 1}, {OP_RESID_FFN, 2, 1},
    {OP_SWIGLU, 3, 0}, {OP_RESID_FFN, 3, 0}, {OP_CONV_IN, 3, 1}, {OP_CONV_EW, 3, 1}, {OP_CONV_OUT, 3, 1}, {OP_SWIGLU, 3, 1}, {OP_RESID_FFN, 3, 1},
};
__device__ const unsigned char BUCKET[128] = {0, 1, 2, 3, 4, 5, 6, 7, 8, 9, 10, 11, 12, 13, 14, 15, 16, 16, 16, 17, 17, 18, 18, 18, 19, 19, 19, 20, 20, 20, 20, 21, 21, 21, 21, 22, 22, 22, 22, 22, 23, 23, 23, 23, 23, 23, 24, 24, 24, 24, 24, 24, 25, 25, 25, 25, 25, 25, 25, 26, 26, 26, 26, 26, 26, 26, 26, 27, 27, 27, 27, 27, 27, 27, 27, 27, 27, 28, 28, 28, 28, 28, 28, 28, 28, 28, 28, 29, 29, 29, 29, 29, 29, 29, 29, 29, 29, 29, 29, 30, 30, 30, 30, 30, 30, 30, 30, 30, 30, 30, 30, 30, 30, 31, 31, 31, 31, 31, 31, 31, 31, 31, 31, 31, 31, 31, 31, 31};

__device__ __forceinline__ float wave_sum(float v) {
#pragma unroll
    for (int o = 1; o < 64; o <<= 1) v += __shfl_xor(v, o);
    return v;
}
__device__ __forceinline__ void transpose_item(const float* W, int K, int N, bf16_t* WT, int mode, const float* gain, const float* nscale, float cmul, LAS float* scr, int item, int lane) {
    const int nblk = N / 32, kb = item / nblk, nb = item % nblk, k0 = 64 * kb, n0 = 32 * nb;
    int row0 = n0;
    if (mode == 1) { const int s = n0 / FF, j = n0 % FF; row0 = 256 * (j / 128) + 128 * s + (j % 128); }
    else if (mode == 2) { if (n0 >= D) { const int c = n0 - D, s = c / D, j = c % D; row0 = D + 256 * (j / 128) + 128 * s + (j % 128); } }
    { const int ks = lane >> 3, n4 = (lane & 7) * 4;
        f32x4 v[8];
#pragma unroll
        for (int i = 0; i < 8; ++i) v[i] = __builtin_nontemporal_load((const f32x4*)(W + (size_t)(k0 + 8 * i + ks) * N + n0 + n4));
#pragma unroll
        for (int i = 0; i < 8; ++i) { LAS float* d = scr + (8 * i + ks) * 33 + n4; d[0] = v[i].x; d[1] = v[i].y; d[2] = v[i].z; d[3] = v[i].w; } }
    asm volatile("s_waitcnt lgkmcnt(0)" ::: "memory");
    const int c = lane & 7;
    f32x4 ga0 = (f32x4){1.f, 1.f, 1.f, 1.f}, gb0 = ga0;
    if (gain) { ga0 = *(const f32x4*)(gain + k0 + 8 * c); gb0 = *(const f32x4*)(gain + k0 + 8 * c + 4); }
#pragma unroll
    for (int j = 0; j < 4; ++j) { const int n = (lane >> 3) + 8 * j; const LAS float* s = scr + (8 * c) * 33 + n;
        const float cs = nscale ? nscale[n0 + n] * cmul : cmul; const f32x4 ga = ga0 * cs, gb = gb0 * cs;
        u32x4 o; o.x = cvtpk(s[0 * 33] * ga.x, s[1 * 33] * ga.y); o.y = cvtpk(s[2 * 33] * ga.z, s[3 * 33] * ga.w); o.z = cvtpk(s[4 * 33] * gb.x, s[5 * 33] * gb.y); o.w = cvtpk(s[6 * 33] * gb.z, s[7 * 33] * gb.w);
        *(u32x4*)(WT + (size_t)(row0 + n) * K + k0 + 8 * c) = o; }
    asm volatile("s_waitcnt lgkmcnt(0)" ::: "memory");
}
__device__ __forceinline__ void xb_rows(const float* x, bf16_t* XL, bf16_t* XB, float* SS, int gw, int NGW, int lane) {
    for (int m = gw; m < M; m += 2 * NGW) {
        const int m2 = m + NGW;
        const f32x4* xr = (const f32x4*)(x + (size_t)m * D) + lane; const f32x4* xr2 = (const f32x4*)(x + (size_t)m2 * D) + lane;
        f32x4 v[4], v2[4]; float s = 0.f, s2 = 0.f;
#pragma unroll
        for (int j = 0; j < 4; ++j) { v[j] = __builtin_nontemporal_load(xr + 64 * j); v2[j] = __builtin_nontemporal_load(xr2 + 64 * j); }
#pragma unroll
        for (int j = 0; j < 4; ++j) { s += (v[j].x * v[j].x + v[j].y * v[j].y) + (v[j].z * v[j].z + v[j].w * v[j].w); s2 += (v2[j].x * v2[j].x + v2[j].y * v2[j].y) + (v2[j].z * v2[j].z + v2[j].w * v2[j].w); }
        s = wave_sum(s); s2 = wave_sum(s2);
        bf16_t* o8 = XB + xt_off(m, 4 * lane); bf16_t* o82 = XB + xt_off(m2, 4 * lane);
        bf16_t* l8 = XL + xt_off(m, 4 * lane); bf16_t* l82 = XL + xt_off(m2, 4 * lane);
#pragma unroll
        for (int j = 0; j < 4; ++j) {
            u32x2 w; w.x = cvtpk(v[j].x, v[j].y); w.y = cvtpk(v[j].z, v[j].w); *(u32x2*)(o8 + j * 8 * 512) = w;
            u32x2 l; l.x = cvtpk(v[j].x - bf_lo(w.x), v[j].y - bf_hi(w.x)); l.y = cvtpk(v[j].z - bf_lo(w.y), v[j].w - bf_hi(w.y)); *(u32x2*)(l8 + j * 8 * 512) = l;
            u32x2 w2; w2.x = cvtpk(v2[j].x, v2[j].y); w2.y = cvtpk(v2[j].z, v2[j].w); *(u32x2*)(o82 + j * 8 * 512) = w2;
            u32x2 l2; l2.x = cvtpk(v2[j].x - bf_lo(w2.x), v2[j].y - bf_hi(w2.x)); l2.y = cvtpk(v2[j].z - bf_lo(w2.y), v2[j].w - bf_hi(w2.y)); *(u32x2*)(l82 + j * 8 * 512) = l2; }
        if (lane < 16) { SS[(size_t)m * 16 + lane] = (lane == 0) ? s : 0.f; SS[(size_t)m2 * 16 + lane] = (lane == 0) ? s2 : 0.f; }
    }
}

__device__ __forceinline__ int crow(int r, int hi) { return (r & 3) + 8 * (r >> 2) + 4 * hi; }
constexpr int KS_STRIDE = 144, VT_STRIDE = 528, KS_BYTES = 256 * KS_STRIDE, VT_BYTES = 64 * VT_STRIDE;
static_assert(KS_BYTES + VT_BYTES + 16 * 128 * 4 <= RING_BYTES, "attention LDS");
__device__ __forceinline__ void attn_phase(LAS unsigned char* lds, const bf16_t* QKV, bf16_t* O, bf16_t* XL, const float* bo, const float* qg, const float* kg, const float* sinks, const float* rel_bias, int vcu, int G, const int tid) {
    const int lane = tid & 63, wid = __builtin_amdgcn_readfirstlane(tid >> 6), r32 = lane & 31, hi = lane >> 5;
    LAS unsigned char* Ks = lds;
    LAS unsigned char* Vt = lds + KS_BYTES;
    LAS float* biasT = (LAS float*)(lds + KS_BYTES + VT_BYTES);
    for (int i = tid; i < 2048; i += 512) { const int h = i >> 7, d = i & 127; biasT[i] = rel_bias[(int)BUCKET[d] * 16 + h]; }
    const int dc = tid & 7;
    float kgv[8];
#pragma unroll
    for (int e = 0; e < 8; ++e) kgv[e] = kg[dc * 8 + e];
    for (int u = vcu; u < 1024; u += G) {
        const int hk = u & 1, nb = (u >> 1) & 63, b = u >> 7;
        const long row_blk = (long)b * SEQ + nb * 128;
#pragma unroll
        for (int i = 0; i < 4; ++i) {
            const int c = tid + 512 * i, key = c >> 3;
            const long row = row_blk - 128 + key;
            const bool ok = (nb > 0) || (key >= 128);
            u32x4 kraw = (u32x4){0u, 0u, 0u, 0u}, vraw = (u32x4){0u, 0u, 0u, 0u};
            if (ok) { const bf16_t* p = QKV + (size_t)row * NQKV + 1024 + hk * 64 + dc * 8; kraw = *(const u32x4*)p; vraw = *(const u32x4*)(p + 128); }
            float kf[8];
            kf[0] = bf_lo(kraw.x); kf[1] = bf_hi(kraw.x); kf[2] = bf_lo(kraw.y); kf[3] = bf_hi(kraw.y); kf[4] = bf_lo(kraw.z); kf[5] = bf_hi(kraw.z); kf[6] = bf_lo(kraw.w); kf[7] = bf_hi(kraw.w);
            float ss = 0.f;
#pragma unroll
            for (int e = 0; e < 8; ++e) ss += kf[e] * kf[e];
            ss += __shfl_xor(ss, 1); ss += __shfl_xor(ss, 2); ss += __shfl_xor(ss, 4);
            const float rstd = 1.0f / sqrtf(ss * (1.f / 64.f) + EPS);
#pragma unroll
            for (int e = 0; e < 8; ++e) kf[e] = kf[e] * rstd * kgv[e];
            u32x4 kw; kw.x = cvtpk(kf[0], kf[1]); kw.y = cvtpk(kf[2], kf[3]); kw.z = cvtpk(kf[4], kf[5]); kw.w = cvtpk(kf[6], kf[7]);
            *(LAS u32x4*)(Ks + key * KS_STRIDE + dc * 16) = kw;
            LAS unsigned char* vp = Vt + (dc * 8) * VT_STRIDE + key * 2;
            *(LAS unsigned short*)(vp + 0 * VT_STRIDE) = (unsigned short)(vraw.x & 0xffffu); *(LAS unsigned short*)(vp + 1 * VT_STRIDE) = (unsigned short)(vraw.x >> 16);
            *(LAS unsigned short*)(vp + 2 * VT_STRIDE) = (unsigned short)(vraw.y & 0xffffu); *(LAS unsigned short*)(vp + 3 * VT_STRIDE) = (unsigned short)(vraw.y >> 16);
            *(LAS unsigned short*)(vp + 4 * VT_STRIDE) = (unsigned short)(vraw.z & 0xffffu); *(LAS unsigned short*)(vp + 5 * VT_STRIDE) = (unsigned short)(vraw.z >> 16);
            *(LAS unsigned short*)(vp + 6 * VT_STRIDE) = (unsigned short)(vraw.w & 0xffffu); *(LAS unsigned short*)(vp + 7 * VT_STRIDE) = (unsigned short)(vraw.w >> 16);
        }
        if (hk == 0) {
#pragma unroll 4
            for (int i = 0; i < 32; ++i) { const int idx = tid + 512 * i, r = idx >> 7, c8 = idx & 127;
                u32x4* lp = (u32x4*)(XL + xt_off((int)row_blk + r, 8 * c8)); const u32x4 lv = *lp; const f32x4 b0 = *((const f32x4*)bo + 2 * c8), b1 = *((const f32x4*)bo + 2 * c8 + 1); u32x4 ln;
                ln.x = cvtpk(bf_lo(lv.x) + b0.x, bf_hi(lv.x) + b0.y); ln.y = cvtpk(bf_lo(lv.y) + b0.z, bf_hi(lv.y) + b0.w);
                ln.z = cvtpk(bf_lo(lv.z) + b1.x, bf_hi(lv.z) + b1.y); ln.w = cvtpk(bf_lo(lv.w) + b1.z, bf_hi(lv.w) + b1.w);
                *lp = ln; }
        }
        __syncthreads();
        const int head = hk * 8 + wid;
        const float sink = sinks[head];
        const LAS float* bT = biasT + head * 128;
        for (int sb = 0; sb < 4; ++sb) {
            const long qrow = row_blk + sb * 32 + r32;
            const bf16_t* qp = QKV + (size_t)qrow * NQKV + head * 64 + hi * 8;
            u32x4 qraw[4];
#pragma unroll
            for (int ds = 0; ds < 4; ++ds) qraw[ds] = *(const u32x4*)(qp + ds * 16);
            float ss = 0.f;
#pragma unroll
            for (int ds = 0; ds < 4; ++ds) {
                const float a0 = bf_lo(qraw[ds].x), a1 = bf_hi(qraw[ds].x), a2 = bf_lo(qraw[ds].y), a3 = bf_hi(qraw[ds].y), a4 = bf_lo(qraw[ds].z), a5 = bf_hi(qraw[ds].z), a6 = bf_lo(qraw[ds].w), a7 = bf_hi(qraw[ds].w);
                ss += (a0 * a0 + a1 * a1) + (a2 * a2 + a3 * a3) + (a4 * a4 + a5 * a5) + (a6 * a6 + a7 * a7);
            }
            ss += __shfl_xor(ss, 32);
            const float qs = 0.125f / sqrtf(ss * (1.f / 64.f) + EPS);
            bf16x8 qf[4];
#pragma unroll
            for (int ds = 0; ds < 4; ++ds) {
                const f32x4 g0 = *(const f32x4*)(qg + ds * 16 + hi * 8), g1 = *(const f32x4*)(qg + ds * 16 + hi * 8 + 4);
                u32x4 w;
                w.x = cvtpk(bf_lo(qraw[ds].x) * qs * g0.x, bf_hi(qraw[ds].x) * qs * g0.y); w.y = cvtpk(bf_lo(qraw[ds].y) * qs * g0.z, bf_hi(qraw[ds].y) * qs * g0.w);
                w.z = cvtpk(bf_lo(qraw[ds].z) * qs * g1.x, bf_hi(qraw[ds].z) * qs * g1.y); w.w = cvtpk(bf_lo(qraw[ds].w) * qs * g1.z, bf_hi(qraw[ds].w) * qs * g1.w);
                qf[ds] = __builtin_bit_cast(bf16x8, w);
            }
            f32x16 S[5];
#pragma unroll
            for (int j = 0; j < 5; ++j) {
                f32x16 a = {};
#pragma unroll
                for (int ds = 0; ds < 4; ++ds) {
                    const bf16x8 kfr = *(const LAS bf16x8*)(Ks + (32 * (sb + j) + r32) * KS_STRIDE + ds * 32 + hi * 16);
                    a = __builtin_amdgcn_mfma_f32_32x32x16_bf16(kfr, qf[ds], a, 0, 0, 0);
                }
                S[j] = a;
            }
            const int qi = sb * 32 + r32;
            float mx = sink;
#pragma unroll
            for (int j = 0; j < 5; ++j)
#pragma unroll
                for (int i = 0; i < 16; ++i) {
                    const int ki = 32 * (sb + j) + crow(i, hi), dist = qi + 128 - ki;
                    const bool valid = (dist >= 0) && (dist < 128) && ((nb > 0) || (ki >= 128));
                    const float s = valid ? S[j][i] + bT[dist & 127] : -INFINITY;
                    S[j][i] = s; mx = fmaxf(mx, s);
                }
            mx = fmaxf(mx, __shfl_xor(mx, 32));
            float l = 0.f;
#pragma unroll
            for (int j = 0; j < 5; ++j)
#pragma unroll
                for (int i = 0; i < 16; ++i) { const float p = __expf(S[j][i] - mx); S[j][i] = p; l += p; }
            l += __shfl_xor(l, 32);
            l += __expf(sink - mx);
            f32x16 o0 = {}, o1 = {};
#pragma unroll
            for (int j = 0; j < 5; ++j)
#pragma unroll
                for (int s = 0; s < 2; ++s) {
                    u32x4 pw; pw.x = cvtpk(S[j][8 * s + 0], S[j][8 * s + 1]); pw.y = cvtpk(S[j][8 * s + 2], S[j][8 * s + 3]); pw.z = cvtpk(S[j][8 * s + 4], S[j][8 * s + 5]); pw.w = cvtpk(S[j][8 * s + 6], S[j][8 * s + 7]);
                    const bf16x8 pf = __builtin_bit_cast(bf16x8, pw);
                    const int keyoff = 32 * (sb + j) + 16 * s + 4 * hi;
                    const LAS unsigned char* v0 = Vt + r32 * VT_STRIDE + keyoff * 2;
                    const LAS unsigned char* v1 = v0 + 32 * VT_STRIDE;
                    const s16x4 a0 = *(const LAS s16x4*)v0, a1 = *(const LAS s16x4*)(v0 + 16);
                    const s16x4 b0 = *(const LAS s16x4*)v1, b1 = *(const LAS s16x4*)(v1 + 16);
                    const bf16x8 vf0 = __builtin_shufflevector(a0, a1, 0, 1, 2, 3, 4, 5, 6, 7), vf1 = __builtin_shufflevector(b0, b1, 0, 1, 2, 3, 4, 5, 6, 7);
                    o0 = __builtin_amdgcn_mfma_f32_32x32x16_bf16(vf0, pf, o0, 0, 0, 0);
                    o1 = __builtin_amdgcn_mfma_f32_32x32x16_bf16(vf1, pf, o1, 0, 0, 0);
                }
            const float inv = 1.0f / l;
            bf16_t* op = O + (size_t)qrow * D + head * 64 + 4 * hi;
#pragma unroll
            for (int i4 = 0; i4 < 4; ++i4) {
                u32x2 w0, w1;
                w0.x = cvtpk(o0[4 * i4 + 0] * inv, o0[4 * i4 + 1] * inv); w0.y = cvtpk(o0[4 * i4 + 2] * inv, o0[4 * i4 + 3] * inv);
                w1.x = cvtpk(o1[4 * i4 + 0] * inv, o1[4 * i4 + 1] * inv); w1.y = cvtpk(o1[4 * i4 + 2] * inv, o1[4 * i4 + 3] * inv);
                *(u32x2*)(op + 8 * i4) = w0; *(u32x2*)(op + 32 + 8 * i4) = w1;
            }
        }
        __syncthreads();
    }
}

#define XB_TMO      128
#define XB_XCNT(j)  (256  + 64 * (j))
#define XB_XSUB(j)  (1280 + 64 * (j))
#define XB_XGEN(j)  (2304 + 64 * (j))
#define XB_TOP      3328
#define XB_TOPGEN   3392
#define XCD_BAR_WORDS 3456
#define XB_SPIN_CAP (1u << 18)
__device__ __forceinline__ unsigned xb_ld(unsigned* p)              { return __hip_atomic_load(p, __ATOMIC_RELAXED, __HIP_MEMORY_SCOPE_AGENT); }
__device__ __forceinline__ unsigned xb_add(unsigned* p, unsigned v) { return __hip_atomic_fetch_add(p, v, __ATOMIC_RELAXED, __HIP_MEMORY_SCOPE_AGENT); }
__device__ __forceinline__ unsigned xb_xcc_id() { return (unsigned)__builtin_amdgcn_s_getreg((3 << 11) | 20) & 0xFu; }
#define XB_SPIN(cond, bar) do { unsigned _sp = 0; while (cond) { __builtin_amdgcn_s_sleep(1); \
    if ((++_sp & 255u) == 0u) { if (xb_ld(&(bar)[XB_TMO])) break; if (_sp > XB_SPIN_CAP) { atomicAdd(&(bar)[XB_TMO], 1u); break; } } } } while (0)
struct XcdBarrier { unsigned* bar; unsigned x; volatile LAS unsigned* st; };
__device__ __forceinline__ XcdBarrier xcd_barrier_post(unsigned* bar, volatile LAS unsigned* st) {
    XcdBarrier b; b.bar = bar; b.x = xb_xcc_id(); b.st = st;
    if (threadIdx.x == 0) (void)xb_add(&bar[XB_XCNT(b.x)], 1u);
    return b;
}
__device__ __forceinline__ void xcd_barrier_complete(unsigned* bar, unsigned x, unsigned& nloc, unsigned& nx) {
    const unsigned G = gridDim.x * gridDim.y * gridDim.z;
    unsigned sum, cnt, mine, sp = 0u;
    for (;;) {
        sum = 0u; cnt = 0u; mine = 0u;
#pragma unroll
        for (unsigned j = 0; j < 16; ++j) { const unsigned c = xb_ld(&bar[XB_XCNT(j)]); sum += c; cnt += (c > 0u) ? 1u : 0u; mine = (j == x) ? c : mine; }
        if (sum == G) break;
        __builtin_amdgcn_s_sleep(1);
        if ((++sp & 255u) == 0u) { if (xb_ld(&bar[XB_TMO])) break; if (sp > XB_SPIN_CAP) { atomicAdd(&bar[XB_TMO], 1u); break; } }
    }
    nloc = mine > 0u ? mine : 1u; nx = cnt > 0u ? cnt : 1u;
}
__device__ __forceinline__ void xcd_barrier(const XcdBarrier& b) {
    asm volatile("s_waitcnt vmcnt(0)" ::: "memory");
    __syncthreads();
    if (threadIdx.x == 0) {
        unsigned* bar = b.bar;
        __builtin_amdgcn_s_waitcnt(0);
        unsigned nloc = b.st[0], nx = b.st[1];
        if (nloc == 0u) { xcd_barrier_complete(bar, b.x, nloc, nx); b.st[0] = nloc; b.st[1] = nx; }
        const unsigned old = xb_add(&bar[XB_XSUB(b.x)], 1u);
        const unsigned gen = old / nloc;
        if (old + 1u == (gen + 1u) * nloc) {
            __builtin_amdgcn_fence(__ATOMIC_RELEASE, "agent");
            asm volatile("s_waitcnt vmcnt(0)" ::: "memory");
            const unsigned og = xb_add(&bar[XB_TOP], 1u);
            const unsigned tg = og / nx;
            if (og + 1u == (tg + 1u) * nx) xb_add(&bar[XB_TOPGEN], 1u);
            else XB_SPIN(xb_ld(&bar[XB_TOPGEN]) == tg, bar);
            __builtin_amdgcn_fence(__ATOMIC_ACQUIRE, "agent");
            xb_add(&bar[XB_XGEN(b.x)], 1u);
            asm volatile("s_waitcnt vmcnt(0)" ::: "memory");
        } else {
            XB_SPIN(xb_ld(&bar[XB_XGEN(b.x)]) == gen, bar);
            __builtin_amdgcn_fence(__ATOMIC_ACQUIRE, "agent");
            asm volatile("s_waitcnt vmcnt(0)" ::: "memory");
        }
    }
    __syncthreads();
}

struct Args { const float* in[22]; float* out; unsigned char* ws; int lo, hi; };
static_assert(sizeof(Args) == 22 * 8 + 8 + 8 + 8, "Args has no padding");

__global__ void __launch_bounds__(512, 2) mk_fwd(Args args) {
    extern __shared__ __attribute__((aligned(16))) unsigned char lds_raw[];
    LAS unsigned char* lds = (LAS unsigned char*)lds_raw;
    cg::grid_group grid = cg::this_grid();
    const int G = gridDim.x, bx = blockIdx.x;
    const int vcu = (G % 8 == 0) ? (bx % 8) * (G / 8) + bx / 8 : bx;
    const int NGW = G * 8;
    volatile LAS unsigned* MISC = (volatile LAS unsigned*)(lds + RING_BYTES + 1024);
    if (threadIdx.x == 0) { MISC[0] = 0u; MISC[1] = 0u; }
    __syncthreads();
    const bool one_launch = (args.hi - args.lo) > 1;
    XcdBarrier bar; bar.bar = (unsigned*)args.ws; bar.x = 0; bar.st = MISC;
    if (one_launch) bar = xcd_barrier_post((unsigned*)args.ws, MISC);

    for (int step = args.lo; step < args.hi; ++step) {
        int tid = threadIdx.x; asm volatile("" : "+v"(tid) :: "memory");
        const int lane = tid & 63, wave = __builtin_amdgcn_readfirstlane(tid >> 6), gw = vcu * 8 + wave;
        const int op = PROG[step][0], L = PROG[step][1], F = PROG[step][2];
        size_t zoff = 0; asm volatile("" : "+s"(zoff));
        unsigned char* ws = args.ws + zoff;
        float* xout = args.out + zoff;
        bf16_t* XL = (bf16_t*)(ws + WS_XL);
        bf16_t* XB = (bf16_t*)(ws + WS_H);
        float* SS = (float*)(ws + WS_SS);
        bf16_t* ACT = (bf16_t*)(ws + WS_ACT);
        bf16_t* WIN = (bf16_t*)(ws + WS_WIN);
        bf16_t* WOUT = (bf16_t*)(ws + WS_WOUT);
        bf16_t* CIN = (bf16_t*)(ws + WS_CIN);
        bf16_t* COUT = (bf16_t*)(ws + WS_COUT);
        bf16_t* POOLW = (bf16_t*)(ws + WS_POOL);
        bf16_t* WQKV = (bf16_t*)(ws + WS_WQKV);
        bf16_t* WO = (bf16_t*)(ws + WS_WO);
        bf16_t* CONV_U = ACT + (size_t)2 * M * D;
        bf16_t* ATT_O = ACT + (size_t)M * NQKV;

        if (op == OP_PROLOGUE) {
            LAS float* scr = (LAS float*)(lds + wave * 16384);
            constexpr int I_FI = (D / 64) * (2 * FF / 32), I_FO = (FF / 64) * (D / 32), I_CI = (D / 64) * (3 * D / 32), I_CO = (D / 64) * (D / 32), I_P = (256 / 64) * (256 / 32), I_Q = (D / 64) * (NQKV / 32);
            constexpr int NITEMS = 8 * I_FI + 8 * I_FO + 2 * I_CI + 2 * I_CO + 4 * I_P + I_Q + I_CO;
            for (int it = gw; it < NITEMS; it += NGW) {
                int r = it;
                if (r < 8 * I_FI) { const int idx = r / I_FI; r %= I_FI; const int l = idx >> 1, f = idx & 1;
                    transpose_item(args.in[f ? 6 : 2] + (size_t)l * WIN_STRIDE, D, 2 * FF, WIN + (size_t)idx * WIN_STRIDE, 1, args.in[f ? 5 : 1] + l * D, nullptr, 1.0f, scr, r, lane); continue; }
                r -= 8 * I_FI;
                if (r < 8 * I_FO) { const int idx = r / I_FO; r %= I_FO; const int l = idx >> 1, f = idx & 1;
                    transpose_item(args.in[f ? 7 : 3] + (size_t)l * WOUT_STRIDE, FF, D, WOUT + (size_t)idx * WOUT_STRIDE, 0, nullptr, nullptr, 0.5f, scr, r, lane); continue; }
                r -= 8 * I_FO;
                if (r < 2 * I_CI) { const int j = r / I_CI; r %= I_CI;
                    transpose_item(args.in[8] + (size_t)j * D * 3 * D, D, 3 * D, CIN + (size_t)j * 3 * D * D, 2, args.in[4] + (j ? 3 : 0) * D, nullptr, 1.0f, scr, r, lane); continue; }
                r -= 2 * I_CI;
                if (r < 2 * I_CO) { const int j = r / I_CO; r %= I_CO;
                    transpose_item(args.in[10] + (size_t)j * D * D, D, D, COUT + (size_t)j * D * D, 0, nullptr, nullptr, 1.0f, scr, r, lane); continue; }
                r -= 2 * I_CO;
                if (r < 4 * I_P) { const int gidx = r / I_P; r %= I_P;
                    transpose_item(args.in[11] + (size_t)gidx * 256 * 256, 256, 256, POOLW + (size_t)gidx * 256 * 256, 0, args.in[4] + 1 * D + gidx * 256, args.in[13] + gidx * 256, 1.0f, scr, r, lane); continue; }
                r -= 4 * I_P;
                if (r < I_Q) { transpose_item(args.in[14], D, NQKV, WQKV, 0, args.in[4] + 2 * D, nullptr, 1.0f, scr, r, lane); continue; }
                r -= I_Q;
                transpose_item(args.in[19], D, D, WO, 0, nullptr, nullptr, 1.0f, scr, r, lane);
            }
            if (gw == 0) { for (int i = lane; i < D; i += 64) ((float*)(ws + WS_PBIAS))[i] = args.in[12][i] * args.in[13][i]; }
            xb_rows(args.in[0], XL, XB, SS, gw, NGW, lane);
        } else if (op == OP_SWIGLU) {
            pg8::Gemm g{XB, WIN + (size_t)(L * 2 + F) * WIN_STRIDE, M, 2 * FF, D, D, 0, 1};
            pg8::StaticOrder S; S.init(M, 2 * FF, G, bx);
            pg8::EpiSwiglu E{ACT, FF, SS};
            pg8::gemm_phase<pg8::EpiSwiglu>(lds, g, S, E, tid);
        } else if (op == OP_RESID_FFN || op == OP_CONV_OUT || op == OP_POOL_GEMM || op == OP_WO) {
            const bf16_t* gA = ACT; const bf16_t* gB = POOLW; int gK = 256, glda = D, gpn = 256;
            if (op == OP_RESID_FFN) { gB = WOUT + (size_t)(L * 2 + F) * WOUT_STRIDE; gK = FF; glda = FF; gpn = 0; }
            else if (op == OP_CONV_OUT) { gA = CONV_U; gB = COUT + (size_t)F * D * D; gK = D; gpn = 0; }
            else if (op == OP_WO) { gA = ATT_O; gB = WO; gK = D; gpn = 0; }
            const pg8::Gemm g{gA, gB, M, D, gK, glda, gpn, (op == OP_RESID_FFN) ? 1 : 0};
            pg8::StaticOrder S; S.init(M, D, G, bx);
            if (step == NSTEPS - 1) { const pg8::EpiResid<true> E{xout, XB, XL, SS}; pg8::gemm_phase<pg8::EpiResid<true>>(lds, g, S, E, tid); }
            else { const pg8::EpiResid<false> E{nullptr, XB, XL, SS}; pg8::gemm_phase<pg8::EpiResid<false>>(lds, g, S, E, tid); }
        } else if (op == OP_CONV_IN) {
            pg8::Gemm g{XB, CIN + (size_t)F * 3 * D * D, M, 3 * D, D, D, 0, 1};
            pg8::StaticOrder S; S.init(M, 3 * D, G, bx);
            pg8::EpiConvIn E{ACT, ACT + (size_t)M * D, SS};
            pg8::gemm_phase<pg8::EpiConvIn>(lds, g, S, E, tid);
        } else if (op == OP_CONV_EW) {
            const bf16_t* Bb = ACT; const bf16_t* Z = ACT + (size_t)M * D; const float* cw = args.in[9] + (size_t)F * 3 * D;
            const int ch = tid & 127, rsub = tid >> 7;
            const f32x4 w0a = *(const f32x4*)(cw + ch * 8), w0b = *(const f32x4*)(cw + ch * 8 + 4);
            const f32x4 w1a = *(const f32x4*)(cw + D + ch * 8), w1b = *(const f32x4*)(cw + D + ch * 8 + 4);
            const f32x4 w2a = *(const f32x4*)(cw + 2 * D + ch * 8), w2b = *(const f32x4*)(cw + 2 * D + ch * 8 + 4);
            for (int grp = vcu; grp < M / 16; grp += G) {
                u32x4 z0[4], z1[4], z2[4], bb[4];
#pragma unroll
                for (int k = 0; k < 4; ++k) {
                    const int row = grp * 16 + k * 4 + rsub, t = row & (SEQ - 1);
                    const size_t off = (size_t)row * D + ch * 8;
                    z0[k] = *(const u32x4*)(Z + off);
                    z1[k] = (t >= 1) ? *(const u32x4*)(Z + off - D) : (u32x4){0u, 0u, 0u, 0u};
                    z2[k] = (t >= 2) ? *(const u32x4*)(Z + off - 2 * D) : (u32x4){0u, 0u, 0u, 0u};
                    bb[k] = *(const u32x4*)(Bb + off);
                }
#pragma unroll
                for (int k = 0; k < 4; ++k) {
                    const int row = grp * 16 + k * 4 + rsub;
                    const size_t off = (size_t)row * D + ch * 8;
                    float r[8];
#define CONV1(q, zz0, zz1, zz2, bbb, wa0, wa1, wa2) r[q] = (bbb) * ((wa0) * (zz2) + (wa1) * (zz1) + (wa2) * (zz0))
                    CONV1(0, bf_lo(z0[k].x), bf_lo(z1[k].x), bf_lo(z2[k].x), bf_lo(bb[k].x), w0a.x, w1a.x, w2a.x);
                    CONV1(1, bf_hi(z0[k].x), bf_hi(z1[k].x), bf_hi(z2[k].x), bf_hi(bb[k].x), w0a.y, w1a.y, w2a.y);
                    CONV1(2, bf_lo(z0[k].y), bf_lo(z1[k].y), bf_lo(z2[k].y), bf_lo(bb[k].y), w0a.z, w1a.z, w2a.z);
                    CONV1(3, bf_hi(z0[k].y), bf_hi(z1[k].y), bf_hi(z2[k].y), bf_hi(bb[k].y), w0a.w, w1a.w, w2a.w);
                    CONV1(4, bf_lo(z0[k].z), bf_lo(z1[k].z), bf_lo(z2[k].z), bf_lo(bb[k].z), w0b.x, w1b.x, w2b.x);
                    CONV1(5, bf_hi(z0[k].z), bf_hi(z1[k].z), bf_hi(z2[k].z), bf_hi(bb[k].z), w0b.y, w1b.y, w2b.y);
                    CONV1(6, bf_lo(z0[k].w), bf_lo(z1[k].w), bf_lo(z2[k].w), bf_lo(bb[k].w), w0b.z, w1b.z, w2b.z);
                    CONV1(7, bf_hi(z0[k].w), bf_hi(z1[k].w), bf_hi(z2[k].w), bf_hi(bb[k].w), w0b.w, w1b.w, w2b.w);
#undef CONV1
                    u32x4 w; w.x = cvtpk(r[0], r[1]); w.y = cvtpk(r[2], r[3]); w.z = cvtpk(r[4], r[5]); w.w = cvtpk(r[6], r[7]);
                    *(u32x4*)(CONV_U + off) = w;
                }
            }
        } else if (op == OP_POOL_DIFF) {
            LAS float* rsl = (LAS float*)lds;
            const float* pbias = (const float*)(ws + WS_PBIAS);
            for (int blk = vcu; blk < M / 64; blk += G) {
                const int row0 = blk * 64, t0 = row0 & (SEQ - 1);
                if (tid < 79) rsl[tid] = (t0 - 15 + tid >= 0) ? pg8::row_rstd(SS, row0 - 15 + tid) : 0.f;
                __syncthreads();
#pragma unroll 1
                for (int it = 0; it < 16; ++it) {
                    const int item = tid + 512 * it, rl = item >> 7, ch = item & 127, t = t0 + rl;
                    const int win = 2 << (ch >> 5), cnt = (t + 1 < win) ? (t + 1) : win;
                    const size_t off = (size_t)(row0 + rl) * D + ch * 8;
                    const u32x4 h0 = *(const u32x4*)(XB + xt_off(row0 + rl, ch * 8));
                    const float r0 = rsl[15 + rl];
                    float s[8], c0[8];
                    c0[0] = bf_lo(h0.x) * r0; c0[1] = bf_hi(h0.x) * r0; c0[2] = bf_lo(h0.y) * r0; c0[3] = bf_hi(h0.y) * r0; c0[4] = bf_lo(h0.z) * r0; c0[5] = bf_hi(h0.z) * r0; c0[6] = bf_lo(h0.w) * r0; c0[7] = bf_hi(h0.w) * r0;
#pragma unroll
                    for (int e = 0; e < 8; ++e) s[e] = c0[e];
                    u32x4 hv[15];
#pragma unroll
                    for (int i = 1; i < 16; ++i) hv[i - 1] = (i < cnt) ? *(const u32x4*)(XB + xt_off(row0 + rl - i, ch * 8)) : (u32x4){0u, 0u, 0u, 0u};
#pragma unroll
                    for (int i = 1; i < 16; ++i) {
                        const float ri = (i < cnt) ? rsl[15 + rl - i] : 0.f;
                        s[0] += bf_lo(hv[i - 1].x) * ri; s[1] += bf_hi(hv[i - 1].x) * ri; s[2] += bf_lo(hv[i - 1].y) * ri; s[3] += bf_hi(hv[i - 1].y) * ri;
                        s[4] += bf_lo(hv[i - 1].z) * ri; s[5] += bf_hi(hv[i - 1].z) * ri; s[6] += bf_lo(hv[i - 1].w) * ri; s[7] += bf_hi(hv[i - 1].w) * ri;
                    }
                    const float ic = 1.0f / (float)cnt;
                    u32x4 w; w.x = cvtpk(s[0] * ic - c0[0], s[1] * ic - c0[1]); w.y = cvtpk(s[2] * ic - c0[2], s[3] * ic - c0[3]);
                    w.z = cvtpk(s[4] * ic - c0[4], s[5] * ic - c0[5]); w.w = cvtpk(s[6] * ic - c0[6], s[7] * ic - c0[7]);
                    *(u32x4*)(ACT + off) = w;
                    const f32x4 pb0 = *(const f32x4*)(pbias + ch * 8), pb1 = *(const f32x4*)(pbias + ch * 8 + 4);
                    u32x4* lp = (u32x4*)(XL + xt_off(row0 + rl, ch * 8)); const u32x4 lv = *lp; u32x4 ln;
                    ln.x = cvtpk(bf_lo(lv.x) + pb0.x, bf_hi(lv.x) + pb0.y); ln.y = cvtpk(bf_lo(lv.y) + pb0.z, bf_hi(lv.y) + pb0.w);
                    ln.z = cvtpk(bf_lo(lv.z) + pb1.x, bf_hi(lv.z) + pb1.y); ln.w = cvtpk(bf_lo(lv.w) + pb1.z, bf_hi(lv.w) + pb1.w);
                    *lp = ln;
                }
                __syncthreads();
            }
        } else if (op == OP_QKV) {
            pg8::Gemm g{XB, WQKV, M, NQKV, D, D, 0, 1};
            pg8::StaticOrder S; S.init(M, NQKV, G, bx);
            pg8::EpiBf16 E{ACT, NQKV, args.in[15], SS};
            pg8::gemm_phase<pg8::EpiBf16>(lds, g, S, E, tid);
        } else if (op == OP_ATTN) {
            attn_phase(lds, ACT, ATT_O, XL, args.in[20], args.in[16], args.in[17], args.in[18], args.in[21], vcu, G, tid);
        }
        if (step + 1 < args.hi) { if (step == args.lo) grid.sync(); else xcd_barrier(bar); }
    }
}

extern "C" void kernel_launch(void* const* d_in, const int* in_sizes, int n_in, void* d_out, int out_size, void* d_ws, size_t ws_size, hipStream_t stream) {
    static int grid = 0;
    if (grid == 0) {
        if (n_in != 22 || out_size != M * D || ws_size < WS_END) { fprintf(stderr, "kernel_launch: unexpected shapes n_in %d out %d ws %zu\n", n_in, out_size, ws_size); grid = -1; return; }
        int dev = 0, cus = 0, per_cu = 0;
        if (hipGetDevice(&dev) != hipSuccess || hipDeviceGetAttribute(&cus, hipDeviceAttributeMultiprocessorCount, dev) != hipSuccess) { grid = -1; return; }
        if (hipFuncSetAttribute((const void*)mk_fwd, hipFuncAttributeMaxDynamicSharedMemorySize, LDS_BYTES) != hipSuccess) { fprintf(stderr, "kernel_launch: hipFuncSetAttribute failed\n"); grid = -1; return; }
        if (hipOccupancyMaxActiveBlocksPerMultiprocessor(&per_cu, (const void*)mk_fwd, 512, LDS_BYTES) != hipSuccess || per_cu < 1) { fprintf(stderr, "kernel_launch: occupancy query says %d\n", per_cu); per_cu = 1; }
        (void)hipGetLastError();
        grid = cus * per_cu;
    }
    if (grid < 0) return;
    Args a{};
    for (int i = 0; i < 22; ++i) a.in[i] = (const float*)d_in[i];
    a.out = (float*)d_out; a.ws = (unsigned char*)d_ws;
#if MK_ONE_LAUNCH
    if (hipMemsetAsync(d_ws, 0, CTL_BYTES, stream) != hipSuccess) { fprintf(stderr, "kernel_launch: memset of control words failed\n"); return; }
    a.lo = 0; a.hi = NSTEPS;
    void* kargs[] = {&a};
    hipError_t e = hipLaunchCooperativeKernel((const void*)mk_fwd, dim3(grid), dim3(512), kargs, LDS_BYTES, stream);
    if (e != hipSuccess) fprintf(stderr, "cooperative launch failed: %s (grid %d)\n", hipGetErrorString(e), grid);
#else
    for (int s = 0; s < NSTEPS; ++s) {
        a.lo = s; a.hi = s + 1;
        hipLaunchKernelGGL(mk_fwd, dim3(grid), dim3(512), LDS_BYTES, stream, a);
    }
#endif
}
```

```cpp
#include <hip/hip_runtime.h>
#include <hip/hip_cooperative_groups.h>
#include <cstdio>
#include <cstdint>
namespace cg = cooperative_groups;

#ifndef MK_ONE_LAUNCH
#define MK_ONE_LAUNCH 1
#endif

#define LAS __attribute__((address_space(3)))
typedef unsigned short bf16_t;
typedef short bf16x8 __attribute__((ext_vector_type(8)));
typedef short s16x4 __attribute__((ext_vector_type(4)));
typedef float f32x4 __attribute__((ext_vector_type(4)));
typedef float f32x16 __attribute__((ext_vector_type(16)));
typedef unsigned u32x4 __attribute__((ext_vector_type(4)));
typedef unsigned u32x2 __attribute__((ext_vector_type(2)));
typedef float f32x2_t __attribute__((ext_vector_type(2)));
typedef __bf16 bf16x2_t __attribute__((ext_vector_type(2)));

constexpr int D = 1024, BATCH = 8, SEQ = 8192, M = BATCH * SEQ, DEPTH = 4, FF = 2816, NQKV = 1280;
constexpr float EPS = 1e-6f;

__device__ __forceinline__ unsigned cvtpk(float lo, float hi) { f32x2_t v = {lo, hi}; bf16x2_t b = __builtin_convertvector(v, bf16x2_t); return __builtin_bit_cast(unsigned, b); }
__device__ __forceinline__ size_t xt_off(int row, int col) { return ((size_t)(row >> 4) * 32 + (col >> 5)) * 512 + (row & 15) * 32 + (col & 31); }
__device__ __forceinline__ float bf_lo(unsigned u) { return __uint_as_float(u << 16); }
__device__ __forceinline__ float bf_hi(unsigned u) { return __uint_as_float(u & 0xffff0000u); }

namespace pg8 {
constexpr int BM = 256, BK = 64, HALF = 128, HTB = HALF * BK * 2, STAGE_BYTES = 8 * HTB, NXCD = 8, WGM = 8;
constexpr int EPI_STG_OFF = 131072 + 2048, EPI_STG_BYTES = 16 * 144;
__host__ __device__ __forceinline__ int lds_byte(int r, int c) { const int st = (r >> 4) * 2 + (c >> 5), rr = r & 15, cc = c & 31, ob = rr * 64 + cc * 2; return st * 1024 + (ob ^ (((ob >> 9) & 1) << 5)); }
__host__ __device__ __forceinline__ void stage_rc(int b, int& R, int& C) { const int st = b / 1024, sb = b % 1024, swz = sb ^ (((sb >> 9) & 1) << 5); R = (st >> 1) * 16 + swz / 64; C = (st & 1) * 32 + (swz % 64) / 2; }
__host__ __device__ __forceinline__ int perm32(int rho) { const int n = rho >> 4, i = rho & 15; return 8 * (i >> 2) + 4 * n + (i & 3); }

struct Unit { int pm, pn; };
struct Gemm { const bf16_t* A; const bf16_t* Bt; int M, N, K, lda, a_pn_off, a_tiled; };

struct StaticOrder {
    int nM, nN, nwg, G, c;
    __host__ __device__ void init(int M_, int N_, int G_, int c_) { nM = M_ / BM; nN = N_ / BM; nwg = nM * nN; G = G_; c = c_; }
    __host__ __device__ bool next(int i, Unit& u) const {
        const long L = (long)i * G + c; if (L >= nwg) return false;
        int wgid = (int)L; { const int q = nwg / NXCD, r = nwg % NXCD, xcd = wgid % NXCD, off = wgid / NXCD; wgid = (xcd < r ? xcd * (q + 1) : r * (q + 1) + (xcd - r) * q) + off; }
        const int nig = WGM * nN, gid = wgid / nig, fm = gid * WGM, gsz = (nM - fm) < WGM ? (nM - fm) : WGM;
        u.pm = fm + ((wgid % nig) % gsz); u.pn = (wgid % nig) / gsz; return true;
    }
};

typedef f32x4 AccT[2][2][4][2];

__device__ __forceinline__ f32x4 gload16(const void* p) { f32x4 v; asm volatile("global_load_dwordx4 %0, %1, off" : "=v"(v) : "v"(p) : "memory"); return v; }
__device__ __forceinline__ f32x4 gload16_nt(const void* p) { f32x4 v; asm volatile("global_load_dwordx4 %0, %1, off nt" : "=v"(v) : "v"(p) : "memory"); return v; }
#define WAIT8(a) asm volatile("s_waitcnt vmcnt(0)" : "+v"(a[0]), "+v"(a[1]), "+v"(a[2]), "+v"(a[3]), "+v"(a[4]), "+v"(a[5]), "+v"(a[6]), "+v"(a[7]) :: "memory")
#define WAIT16(a) asm volatile("s_waitcnt vmcnt(0)" : "+v"(a[0]), "+v"(a[1]), "+v"(a[2]), "+v"(a[3]), "+v"(a[4]), "+v"(a[5]), "+v"(a[6]), "+v"(a[7]), "+v"(a[8]), "+v"(a[9]), "+v"(a[10]), "+v"(a[11]), "+v"(a[12]), "+v"(a[13]), "+v"(a[14]), "+v"(a[15]) :: "memory")
__device__ __forceinline__ float row_rstd(const float* SS, int row) {
    const f32x4* p = (const f32x4*)(SS + (size_t)row * 16);
    const f32x4 a = p[0], b = p[1], c = p[2], d = p[3];
    const f32x4 s = (a + b) + (c + d);
    return 1.0f / sqrtf(((s.x + s.y) + (s.z + s.w)) * (1.f / D) + EPS);
}
__device__ __forceinline__ void rows_rstd(const float* SS, int row0, int fq, float (&rs)[2][4]) {
    f32x4 p[8];
#pragma unroll
    for (int i = 0; i < 8; ++i) p[i] = gload16(SS + (size_t)(row0 + (i >> 2) * HALF + (i & 3) * 16) * 16 + fq * 4);
    WAIT8(p);
#pragma unroll
    for (int i = 0; i < 8; ++i) {
        float s = (p[i].x + p[i].y) + (p[i].z + p[i].w);
        s += __shfl_xor(s, 16); s += __shfl_xor(s, 32);
        rs[i >> 2][i & 3] = __builtin_amdgcn_rsqf(s * (1.f / D) + EPS);
    }
}
__device__ __forceinline__ void rows_rstd_issue(const float* SS, int row0, int fq, f32x4 (&p)[8]) {
#pragma unroll
    for (int i = 0; i < 8; ++i) p[i] = gload16(SS + (size_t)(row0 + (i >> 2) * HALF + (i & 3) * 16) * 16 + fq * 4);
}
__device__ __forceinline__ void rows_rstd_finish(f32x4 (&p)[8], float (&rs)[2][4]) {
    WAIT8(p);
#pragma unroll
    for (int i = 0; i < 8; ++i) {
        float s = (p[i].x + p[i].y) + (p[i].z + p[i].w);
        s += __shfl_xor(s, 16); s += __shfl_xor(s, 32);
        rs[i >> 2][i & 3] = __builtin_amdgcn_rsqf(s * (1.f / D) + EPS);
    }
}
struct EpiSwiglu {
    static constexpr bool WIDE = false, NEXT_RS = false;
    bf16_t* O; int ldo; const float* SS;
    __device__ __forceinline__ void operator()(const AccT& acc, const Unit& u, int wr, int wc, int fr, int fq, LAS unsigned char* stg) const {
        const int row0 = u.pm * BM + wr * 64 + fr;
        float rs[2][4];
        rows_rstd(SS, row0, fq, rs);
#pragma unroll
        for (int ai = 0; ai < 2; ++ai)
#pragma unroll
            for (int m = 0; m < 4; ++m) {
                bf16_t* rowp = O + ((size_t)(u.pm * 16 + wr * 4 + ai * 8 + m) * (ldo >> 5) + (u.pn * 4 + wc)) * 512 + fr * 32 + 8 * fq;
                const float k1 = rs[ai][m] * -1.4426950408889634f, k2 = rs[ai][m] * rs[ai][m];
                float r[8];
#pragma unroll
                for (int n = 0; n < 2; ++n)
#pragma unroll
                    for (int i = 0; i < 4; ++i) {
                        const float g = acc[ai][0][m][n][i], up = acc[ai][1][m][n][i];
                        const float e = __builtin_amdgcn_exp2f(g * k1);
                        r[n * 4 + i] = (g * up) * (k2 * __builtin_amdgcn_rcpf(1.0f + e));
                    }
                u32x4 w; w.x = cvtpk(r[0], r[1]); w.y = cvtpk(r[2], r[3]); w.z = cvtpk(r[4], r[5]); w.w = cvtpk(r[6], r[7]);
                __builtin_nontemporal_store(w, (u32x4*)rowp);
            }
    }
};
template <bool LAST> struct EpiResid {
    static constexpr bool WIDE = true, NEXT_RS = false;
    float* fout; bf16_t* XB; bf16_t* XL; float* SS;
    __device__ __forceinline__ void operator()(const AccT& acc, const Unit& u, int wr, int wc, int fr, int fq, LAS unsigned char* stg) const {
        const int row0 = u.pm * BM + wr * 64 + fr, col0 = u.pn * BM + wc * 64 + 8 * fq;
        const size_t blk0 = ((size_t)(u.pm * 16 + wr * 4) * 32 + (u.pn * 8 + wc * 2)) * 512 + fr * 32 + 8 * fq;
        constexpr bool last = LAST;
#pragma unroll
        for (int ai = 0; ai < 2; ++ai) {
            f32x4 pre[16];
#pragma unroll
            for (int m = 0; m < 4; ++m) {
                const size_t boff = blk0 + (size_t)(ai * 8 + m) * (32 * 512);
                pre[m * 4 + 0] = gload16_nt(XB + boff); pre[m * 4 + 1] = gload16_nt(XB + boff + 512); pre[m * 4 + 2] = gload16_nt(XL + boff); pre[m * 4 + 3] = gload16_nt(XL + boff + 512);
            }
            WAIT16(pre);
#pragma unroll
            for (int m = 0; m < 4; ++m) {
                const size_t boff = blk0 + (size_t)(ai * 8 + m) * (32 * 512);
                const size_t off = (size_t)(row0 + ai * HALF + m * 16) * D + col0;
                float ssq = 0.f;
#pragma unroll
                for (int bj = 0; bj < 2; ++bj) {
                    const u32x4 hi = __builtin_bit_cast(u32x4, pre[m * 4 + bj]), lo = __builtin_bit_cast(u32x4, pre[m * 4 + 2 + bj]);
                    f32x4 o0, o1;
                    o0.x = bf_lo(hi.x) + bf_lo(lo.x); o0.y = bf_hi(hi.x) + bf_hi(lo.x); o0.z = bf_lo(hi.y) + bf_lo(lo.y); o0.w = bf_hi(hi.y) + bf_hi(lo.y);
                    o1.x = bf_lo(hi.z) + bf_lo(lo.z); o1.y = bf_hi(hi.z) + bf_hi(lo.z); o1.z = bf_lo(hi.w) + bf_lo(lo.w); o1.w = bf_hi(hi.w) + bf_hi(lo.w);
                    o0 += acc[ai][bj][m][0]; o1 += acc[ai][bj][m][1];
                    if constexpr (last) { *(f32x4*)(fout + off + bj * 32) = o0; *(f32x4*)(fout + off + bj * 32 + 4) = o1; }
                    else {
                        ssq += (o0.x * o0.x + o0.y * o0.y) + (o0.z * o0.z + o0.w * o0.w) + (o1.x * o1.x + o1.y * o1.y) + (o1.z * o1.z + o1.w * o1.w);
                        u32x4 w; w.x = cvtpk(o0.x, o0.y); w.y = cvtpk(o0.z, o0.w); w.z = cvtpk(o1.x, o1.y); w.w = cvtpk(o1.z, o1.w);
                        *(u32x4*)(XB + boff + bj * 512) = w;
                        u32x4 l;
                        l.x = cvtpk(o0.x - bf_lo(w.x), o0.y - bf_hi(w.x)); l.y = cvtpk(o0.z - bf_lo(w.y), o0.w - bf_hi(w.y));
                        l.z = cvtpk(o1.x - bf_lo(w.z), o1.y - bf_hi(w.z)); l.w = cvtpk(o1.z - bf_lo(w.w), o1.w - bf_hi(w.w));
                        __builtin_nontemporal_store(l, (u32x4*)(XL + boff + bj * 512));
                    }
                }
                if constexpr (!last) {
                    ssq += __shfl_xor(ssq, 16); ssq += __shfl_xor(ssq, 32);
                    if (fq == 0) SS[(size_t)(row0 + ai * HALF + m * 16) * 16 + u.pn * 4 + wc] = ssq;
                }
            }
        }
    }
};
struct EpiBf16 {
    static constexpr bool WIDE = false, NEXT_RS = false;
    bf16_t* O; int ldo; const float* bias; const float* SS;
    __device__ __forceinline__ void operator()(const AccT& acc, const Unit& u, int wr, int wc, int fr, int fq, LAS unsigned char* stg) const {
        const int row0 = u.pm * BM + wr * 64 + fr, col0 = u.pn * BM + wc * 32 + 8 * fq;
        f32x4 bv[2][2];
#pragma unroll
        for (int bj = 0; bj < 2; ++bj)
#pragma unroll
            for (int n = 0; n < 2; ++n) bv[bj][n] = *(const f32x4*)(bias + col0 + bj * HALF + 4 * n);
        float rsv[2][4];
        rows_rstd(SS, row0, fq, rsv);
#pragma unroll
        for (int ai = 0; ai < 2; ++ai)
#pragma unroll
            for (int m = 0; m < 4; ++m) {
                bf16_t* rowp = O + (size_t)(row0 + ai * HALF + m * 16) * ldo + col0;
                const float rs = rsv[ai][m];
#pragma unroll
                for (int bj = 0; bj < 2; ++bj) {
                    const f32x4 v0 = acc[ai][bj][m][0] * rs + bv[bj][0], v1 = acc[ai][bj][m][1] * rs + bv[bj][1];
                    u32x4 w; w.x = cvtpk(v0[0], v0[1]); w.y = cvtpk(v0[2], v0[3]); w.z = cvtpk(v1[0], v1[1]); w.w = cvtpk(v1[2], v1[3]);
                    *(u32x4*)(rowp + bj * HALF) = w;
                }
            }
    }
};
struct EpiConvIn {
    static constexpr bool WIDE = false, NEXT_RS = false;
    bf16_t* Bb; bf16_t* Z; const float* SS;
    __device__ __forceinline__ void operator()(const AccT& acc, const Unit& u, int wr, int wc, int fr, int fq, LAS unsigned char* stg) const {
        const int row0 = u.pm * BM + wr * 64 + fr;
        float rsv[2][4];
        rows_rstd(SS, row0, fq, rsv);
        if (u.pn < 4) {
            const int col0 = u.pn * BM + wc * 32 + 8 * fq;
#pragma unroll
            for (int ai = 0; ai < 2; ++ai)
#pragma unroll
                for (int m = 0; m < 4; ++m) {
                    bf16_t* rowp = Bb + (size_t)(row0 + ai * HALF + m * 16) * D + col0;
                    const float rs = rsv[ai][m];
#pragma unroll
                    for (int bj = 0; bj < 2; ++bj) {
                        const f32x4 v0 = acc[ai][bj][m][0] * rs, v1 = acc[ai][bj][m][1] * rs;
                        u32x4 w; w.x = cvtpk(v0[0], v0[1]); w.y = cvtpk(v0[2], v0[3]); w.z = cvtpk(v1[0], v1[1]); w.w = cvtpk(v1[2], v1[3]);
                        *(u32x4*)(rowp + bj * HALF) = w;
                    }
                }
        } else {
            const int col0 = (u.pn - 4) * HALF + wc * 32 + 8 * fq;
#pragma unroll
            for (int ai = 0; ai < 2; ++ai)
#pragma unroll
                for (int m = 0; m < 4; ++m) {
                    bf16_t* rowp = Z + (size_t)(row0 + ai * HALF + m * 16) * D + col0;
                    const float rs = rsv[ai][m], rs2 = rs * rs;
                    const f32x4 v0 = acc[ai][0][m][0] * acc[ai][1][m][0] * rs2, v1 = acc[ai][0][m][1] * acc[ai][1][m][1] * rs2;
                    u32x4 w; w.x = cvtpk(v0[0], v0[1]); w.y = cvtpk(v0[2], v0[3]); w.z = cvtpk(v1[0], v1[1]); w.w = cvtpk(v1[2], v1[3]);
                    *(u32x4*)rowp = w;
                }
        }
    }
};

template <class Epi>
__device__ __forceinline__ void gemm_phase(LAS unsigned char* lds, const Gemm g, const StaticOrder& S, const Epi& E, const int tid) {
    const int wid = __builtin_amdgcn_readfirstlane(tid >> 6), lane = tid & 63, wr = wid >> 2, wc = wid & 3, fr = lane & 15, fq = lane >> 4;
    const int K = g.K, nt = K / BK, lda = g.lda;
    unsigned voffA[2], voffB[2];
#pragma unroll
    for (int i = 0; i < 2; ++i) { int R, C; stage_rc(tid * 16 + i * 8192, R, C); const int Rb = Epi::WIDE ? (64 * (R >> 5) + perm32(R & 31)) : ((R & ~31) + perm32(R & 31));
        voffA[i] = g.a_tiled ? (unsigned)(((R >> 4) * (lda >> 5) + (C >> 5)) * 512 + (R & 15) * 32 + (C & 31)) * 2u : (unsigned)(R * lda + C) * 2u; voffB[i] = (unsigned)(Rb * K + C) * 2u; }
    const size_t kstep = (size_t)(BK * 2), kstepA = g.a_tiled ? (size_t)2048 : kstep;
    const size_t hstepA = (size_t)HALF * lda * 2, tstepA = 2 * hstepA;
    const size_t hstepB = (size_t)(Epi::WIDE ? 32 : HALF) * K * 2, tstepB = (size_t)BM * K * 2;
    const size_t pnoffA = (size_t)g.a_pn_off * 2;
    const unsigned ldsw = (unsigned)wid * 1024u;
    const int aoff = lds_byte(wr * 64 + fr, fq * 8), boff = lds_byte(wc * 32 + fr, fq * 8);
#define PG8_SA(b, h) (((b) * 2 + (h)) * HTB)
#define PG8_SB(b, h) ((4 + (b) * 2 + (h)) * HTB)
#define PG8_STAGE(bufoff, gbase, voff) do { _Pragma("unroll") for (int _i = 0; _i < 2; ++_i) \
        __builtin_amdgcn_global_load_lds((const unsigned*)((const char*)(gbase) + (voff)[_i]), (LAS unsigned*)(lds + (bufoff) + ldsw + _i * 8192), 16, 0, 0); } while (0)
#define PG8_LDA(dst, b, h) do { _Pragma("unroll") for (int m = 0; m < 4; ++m) _Pragma("unroll") for (int k = 0; k < 2; ++k) dst[m][k] = *(const LAS bf16x8*)(lds + PG8_SA(b, h) + aoff + m * 2048 + k * 1024); } while (0)
#define PG8_LDB(dst, b, h) do { _Pragma("unroll") for (int n = 0; n < 2; ++n) _Pragma("unroll") for (int k = 0; k < 2; ++k) dst[n][k] = *(const LAS bf16x8*)(lds + PG8_SB(b, h) + boff + n * 2048 + k * 1024); } while (0)
#define PG8_MMA(ai, bj, At, Bt) do { __builtin_amdgcn_s_setprio(1); _Pragma("unroll") for (int m = 0; m < 4; ++m) _Pragma("unroll") for (int n = 0; n < 2; ++n) _Pragma("unroll") for (int k = 0; k < 2; ++k) \
        acc[ai][bj][m][n] = __builtin_amdgcn_mfma_f32_16x16x32_bf16(Bt[n][k], At[m][k], acc[ai][bj][m][n], 0, 0, 0); __builtin_amdgcn_s_setprio(0); } while (0)
#define PG8_WAIT_V(n) asm volatile("s_waitcnt vmcnt(" #n ")" ::: "memory")
#define PG8_WAIT_L(n) asm volatile("s_waitcnt lgkmcnt(" #n ")" ::: "memory")
#define PG8_BAR __builtin_amdgcn_s_barrier()
#define PG8_SCHED __builtin_amdgcn_sched_barrier(0)
    Unit cur, nxt; int ui = 0;
    if (!S.next(0, cur)) return;
    float rs[2][4];
    if constexpr (Epi::NEXT_RS) rows_rstd(E.SS, cur.pm * BM + wr * 64 + fr, fq, rs);
    f32x4 acc[2][2][4][2];
#pragma unroll
    for (int a = 0; a < 2; ++a)
#pragma unroll
        for (int b = 0; b < 2; ++b)
#pragma unroll
            for (int m = 0; m < 4; ++m)
#pragma unroll
                for (int n = 0; n < 2; ++n) acc[a][b][m][n] = (f32x4){0.f, 0.f, 0.f, 0.f};
    bf16x8 At[4][2], B0[2][2], B1[2][2];
    const char* cA = (const char*)g.A + (size_t)cur.pm * tstepA + (size_t)cur.pn * pnoffA; const char* cB = (const char*)g.Bt + (size_t)cur.pn * tstepB;
    PG8_STAGE(PG8_SB(0, 0), cB, voffB); PG8_STAGE(PG8_SB(0, 1), cB + hstepB, voffB); PG8_STAGE(PG8_SA(0, 0), cA, voffA); PG8_STAGE(PG8_SA(0, 1), cA + hstepA, voffA);
    if (wr == 1) PG8_BAR;
    PG8_WAIT_V(2); PG8_BAR;
    PG8_STAGE(PG8_SB(1, 0), cB + kstep, voffB); PG8_STAGE(PG8_SA(1, 0), cA + kstepA, voffA); PG8_STAGE(PG8_SB(1, 1), cB + hstepB + kstep, voffB);
    PG8_WAIT_V(6); PG8_BAR;
    for (;;) {
        const bool has_next = S.next(ui + 1, nxt);
        const char* nA = has_next ? (const char*)g.A + (size_t)nxt.pm * tstepA + (size_t)nxt.pn * pnoffA : cA; const char* nB = has_next ? (const char*)g.Bt + (size_t)nxt.pn * tstepB : cB;
        for (int t = 0; t < nt; t += 2) {
            const bool last = (t == nt - 2);
            const char* a1 = cA + (size_t)(t + 1) * kstepA;
            const char* a2 = last ? nA : cA + (size_t)(t + 2) * kstepA; const char* b2 = last ? nB : cB + (size_t)(t + 2) * kstep;
            const char* a3 = a2 + kstepA; const char* b3 = b2 + kstep;
            PG8_LDB(B0, 0, 0); PG8_LDB(B1, 0, 1); PG8_SCHED; PG8_LDA(At, 0, 0); PG8_STAGE(PG8_SA(1, 1), a1 + hstepA, voffA);
            PG8_WAIT_V(8); PG8_WAIT_L(0); PG8_BAR; PG8_MMA(0, 0, At, B0); PG8_MMA(0, 1, At, B1); PG8_BAR; PG8_SCHED;
            PG8_LDA(At, 0, 1); PG8_STAGE(PG8_SB(0, 0), b2, voffB); PG8_STAGE(PG8_SB(0, 1), b2 + hstepB, voffB); PG8_STAGE(PG8_SA(0, 0), a2, voffA);
            PG8_WAIT_V(8); PG8_WAIT_L(0); PG8_BAR; PG8_MMA(1, 0, At, B0); PG8_MMA(1, 1, At, B1); PG8_BAR; PG8_SCHED;
            PG8_LDB(B0, 1, 0); PG8_LDB(B1, 1, 1); PG8_SCHED; PG8_LDA(At, 1, 0); PG8_STAGE(PG8_SA(0, 1), a2 + hstepA, voffA);
            PG8_WAIT_V(8); PG8_WAIT_L(0); PG8_BAR; PG8_MMA(0, 0, At, B0); PG8_MMA(0, 1, At, B1); PG8_BAR; PG8_SCHED;
            PG8_LDA(At, 1, 1); PG8_STAGE(PG8_SB(1, 0), b3, voffB); PG8_STAGE(PG8_SB(1, 1), b3 + hstepB, voffB); PG8_STAGE(PG8_SA(1, 0), a3, voffA);
            PG8_WAIT_V(8); PG8_WAIT_L(0); PG8_BAR; PG8_MMA(1, 0, At, B0); PG8_MMA(1, 1, At, B1); PG8_BAR; PG8_SCHED;
        }
        if (wr == 0) PG8_BAR;
        if constexpr (Epi::NEXT_RS) E(acc, cur, wr, wc, fr, fq, lds + EPI_STG_OFF + wid * EPI_STG_BYTES, rs, has_next ? nxt.pm : cur.pm);
        else E(acc, cur, wr, wc, fr, fq, lds + EPI_STG_OFF + wid * EPI_STG_BYTES);
        if (!has_next) break;
#pragma unroll
        for (int a = 0; a < 2; ++a)
#pragma unroll
            for (int b = 0; b < 2; ++b)
#pragma unroll
                for (int m = 0; m < 4; ++m)
#pragma unroll
                    for (int n = 0; n < 2; ++n) acc[a][b][m][n] = (f32x4){0.f, 0.f, 0.f, 0.f};
        cur = nxt; cA = nA; cB = nB; ++ui;
        if (wr == 1) PG8_BAR;
    }
    PG8_WAIT_V(0);
    PG8_BAR;
#undef PG8_SA
#undef PG8_SB
#undef PG8_STAGE
#undef PG8_LDA
#undef PG8_LDB
#undef PG8_MMA
#undef PG8_WAIT_V
#undef PG8_WAIT_L
#undef PG8_BAR
#undef PG8_SCHED
}
}

constexpr size_t MiB = 1u << 20;
constexpr size_t WS_WIN = 2 * MiB;
constexpr size_t WS_WOUT = WS_WIN + 88 * MiB;
constexpr size_t WS_CIN = WS_WOUT + 44 * MiB;
constexpr size_t WS_COUT = WS_CIN + 12 * MiB;
constexpr size_t WS_POOL = WS_COUT + 4 * MiB;
constexpr size_t WS_WQKV = WS_POOL + 1 * MiB;
constexpr size_t WS_WO = WS_WQKV + 3 * MiB;
constexpr size_t WS_SS = 156 * MiB;
constexpr size_t WS_H = 160 * MiB;
constexpr size_t WS_ACT = 288 * MiB;
constexpr size_t WS_XL = 672 * MiB;
constexpr size_t WS_END = 800 * MiB;
constexpr size_t WS_ZEROS = 1 * MiB, WS_PBIAS = 1 * MiB + 4096;
constexpr size_t CTL_BYTES = 65536;
static_assert(WS_WO + 2 * MiB <= WS_SS, "ws map");
constexpr size_t WIN_STRIDE = (size_t)2 * FF * D;
constexpr size_t WOUT_STRIDE = (size_t)D * FF;

constexpr int RING_BYTES = 131072, LDS_BYTES = 155648;
static_assert(pg8::EPI_STG_OFF + 8 * pg8::EPI_STG_BYTES <= LDS_BYTES, "LDS map");

enum Op { OP_PROLOGUE = 0, OP_SWIGLU, OP_RESID_FFN, OP_CONV_IN, OP_CONV_EW, OP_CONV_OUT, OP_POOL_DIFF, OP_POOL_GEMM, OP_QKV, OP_ATTN, OP_WO };
constexpr int NSTEPS = 28;
__device__ const unsigned char PROG[NSTEPS][3] = {
    {OP_PROLOGUE, 0, 0},
    {OP_SWIGLU, 0, 0}, {OP_RESID_FFN, 0, 0}, {OP_CONV_IN, 0, 0}, {OP_CONV_EW, 0, 0}, {OP_CONV_OUT, 0, 0}, {OP_SWIGLU, 0, 1}, {OP_RESID_FFN, 0, 1},
    {OP_SWIGLU, 1, 0}, {OP_RESID_FFN, 1, 0}, {OP_POOL_DIFF, 1, 0}, {OP_POOL_GEMM, 1, 0}, {OP_SWIGLU, 1, 1}, {OP_RESID_FFN, 1, 1},
    {OP_SWIGLU, 2, 0}, {OP_RESID_FFN, 2, 0}, {OP_QKV, 2, 0}, {OP_ATTN, 2, 0}, {OP_WO, 2, 0}, {OP_SWIGLU, 2, 1}, {OP_RESID_FFN, 2, 1},
    {OP_SWIGLU, 3, 0}, {OP_RESID_FFN, 3, 0}, {OP_CONV_IN, 3, 1}, {OP_CONV_EW, 3, 1}, {OP_CONV_OUT, 3, 1}, {OP_SWIGLU, 3, 1}, {OP_RESID_FFN, 3, 1},
};
__device__ const unsigned char BUCKET[128] = {0, 1, 2, 3, 4, 5, 6, 7, 8, 9, 10, 11, 12, 13, 14, 15, 16, 16, 16, 17, 17, 18, 18, 18, 19, 19, 19, 20, 20, 20, 20, 21, 21, 21, 21, 22, 22, 22, 22, 22, 23, 23, 23, 23, 23, 23, 24, 24, 24, 24, 24, 24, 25, 25, 25, 25, 25, 25, 25, 26, 26, 26, 26, 26, 26, 26, 26, 27, 27, 27, 27, 27, 27, 27, 27, 27, 27, 28, 28, 28, 28, 28, 28, 28, 28, 28, 28, 29, 29, 29, 29, 29, 29, 29, 29, 29, 29, 29, 29, 30, 30, 30, 30, 30, 30, 30, 30, 30, 30, 30, 30, 30, 30, 31, 31, 31, 31, 31, 31, 31, 31, 31, 31, 31, 31, 31, 31, 31};

__device__ __forceinline__ float wave_sum(float v) {
#pragma unroll
    for (int o = 1; o < 64; o <<= 1) v += __shfl_xor(v, o);
    return v;
}
__device__ __forceinline__ void transpose_item(const float* W, int K, int N, bf16_t* WT, int mode, const float* gain, const float* nscale, float cmul, LAS float* scr, int item, int lane) {
    const int nblk = N / 32, kb = item / nblk, nb = item % nblk, k0 = 64 * kb, n0 = 32 * nb;
    int row0 = n0;
    if (mode == 1) { const int s = n0 / FF, j = n0 % FF; row0 = 256 * (j / 128) + 128 * s + (j % 128); }
    else if (mode == 2) { if (n0 >= D) { const int c = n0 - D, s = c / D, j = c % D; row0 = D + 256 * (j / 128) + 128 * s + (j % 128); } }
    { const int ks = lane >> 3, n4 = (lane & 7) * 4;
        f32x4 v[8];
#pragma unroll
        for (int i = 0; i < 8; ++i) v[i] = __builtin_nontemporal_load((const f32x4*)(W + (size_t)(k0 + 8 * i + ks) * N + n0 + n4));
#pragma unroll
        for (int i = 0; i < 8; ++i) { LAS float* d = scr + (8 * i + ks) * 33 + n4; d[0] = v[i].x; d[1] = v[i].y; d[2] = v[i].z; d[3] = v[i].w; } }
    asm volatile("s_waitcnt lgkmcnt(0)" ::: "memory");
    const int c = lane & 7;
    f32x4 ga0 = (f32x4){1.f, 1.f, 1.f, 1.f}, gb0 = ga0;
    if (gain) { ga0 = *(const f32x4*)(gain + k0 + 8 * c); gb0 = *(const f32x4*)(gain + k0 + 8 * c + 4); }
#pragma unroll
    for (int j = 0; j < 4; ++j) { const int n = (lane >> 3) + 8 * j; const LAS float* s = scr + (8 * c) * 33 + n;
        const float cs = nscale ? nscale[n0 + n] * cmul : cmul; const f32x4 ga = ga0 * cs, gb = gb0 * cs;
        u32x4 o; o.x = cvtpk(s[0 * 33] * ga.x, s[1 * 33] * ga.y); o.y = cvtpk(s[2 * 33] * ga.z, s[3 * 33] * ga.w); o.z = cvtpk(s[4 * 33] * gb.x, s[5 * 33] * gb.y); o.w = cvtpk(s[6 * 33] * gb.z, s[7 * 33] * gb.w);
        *(u32x4*)(WT + (size_t)(row0 + n) * K + k0 + 8 * c) = o; }
    asm volatile("s_waitcnt lgkmcnt(0)" ::: "memory");
}
__device__ __forceinline__ void xb_rows(const float* x, bf16_t* XL, bf16_t* XB, float* SS, int gw, int NGW, int lane) {
    for (int m = gw; m < M; m += 2 * NGW) {
        const int m2 = m + NGW;
        const f32x4* xr = (const f32x4*)(x + (size_t)m * D) + lane; const f32x4* xr2 = (const f32x4*)(x + (size_t)m2 * D) + lane;
        f32x4 v[4], v2[4]; float s = 0.f, s2 = 0.f;
#pragma unroll
        for (int j = 0; j < 4; ++j) { v[j] = __builtin_nontemporal_load(xr + 64 * j); v2[j] = __builtin_nontemporal_load(xr2 + 64 * j); }
#pragma unroll
        for (int j = 0; j < 4; ++j) { s += (v[j].x * v[j].x + v[j].y * v[j].y) + (v[j].z * v[j].z + v[j].w * v[j].w); s2 += (v2[j].x * v2[j].x + v2[j].y * v2[j].y) + (v2[j].z * v2[j].z + v2[j].w * v2[j].w); }
        s = wave_sum(s); s2 = wave_sum(s2);
        bf16_t* o8 = XB + xt_off(m, 4 * lane); bf16_t* o82 = XB + xt_off(m2, 4 * lane);
        bf16_t* l8 = XL + xt_off(m, 4 * lane); bf16_t* l82 = XL + xt_off(m2, 4 * lane);
#pragma unroll
        for (int j = 0; j < 4; ++j) {
            u32x2 w; w.x = cvtpk(v[j].x, v[j].y); w.y = cvtpk(v[j].z, v[j].w); *(u32x2*)(o8 + j * 8 * 512) = w;
            u32x2 l; l.x = cvtpk(v[j].x - bf_lo(w.x), v[j].y - bf_hi(w.x)); l.y = cvtpk(v[j].z - bf_lo(w.y), v[j].w - bf_hi(w.y)); *(u32x2*)(l8 + j * 8 * 512) = l;
            u32x2 w2; w2.x = cvtpk(v2[j].x, v2[j].y); w2.y = cvtpk(v2[j].z, v2[j].w); *(u32x2*)(o82 + j * 8 * 512) = w2;
            u32x2 l2; l2.x = cvtpk(v2[j].x - bf_lo(w2.x), v2[j].y - bf_hi(w2.x)); l2.y = cvtpk(v2[j].z - bf_lo(w2.y), v2[j].w - bf_hi(w2.y)); *(u32x2*)(l82 + j * 8 * 512) = l2; }
        if (lane < 16) { SS[(size_t)m * 16 + lane] = (lane == 0) ? s : 0.f; SS[(size_t)m2 * 16 + lane] = (lane == 0) ? s2 : 0.f; }
    }
}

__device__ __forceinline__ int crow(int r, int hi) { return (r & 3) + 8 * (r >> 2) + 4 * hi; }
constexpr int KS_STRIDE = 144, VT_STRIDE = 528, KS_BYTES = 256 * KS_STRIDE, VT_BYTES = 64 * VT_STRIDE;
static_assert(KS_BYTES + VT_BYTES + 16 * 128 * 4 <= RING_BYTES, "attention LDS");
__device__ __forceinline__ void attn_phase(LAS unsigned char* lds, const bf16_t* QKV, bf16_t* O, bf16_t* XL, const float* bo, const float* qg, const float* kg, const float* sinks, const float* rel_bias, int vcu, int G, const int tid) {
    const int lane = tid & 63, wid = __builtin_amdgcn_readfirstlane(tid >> 6), r32 = lane & 31, hi = lane >> 5;
    LAS unsigned char* Ks = lds;
    LAS unsigned char* Vt = lds + KS_BYTES;
    LAS float* biasT = (LAS float*)(lds + KS_BYTES + VT_BYTES);
    for (int i = tid; i < 2048; i += 512) { const int h = i >> 7, d = i & 127; biasT[i] = rel_bias[(int)BUCKET[d] * 16 + h]; }
    const int dc = tid & 7;
    float kgv[8];
#pragma unroll
    for (int e = 0; e < 8; ++e) kgv[e] = kg[dc * 8 + e];
    for (int u = vcu; u < 1024; u += G) {
        const int hk = u & 1, nb = (u >> 1) & 63, b = u >> 7;
        const long row_blk = (long)b * SEQ + nb * 128;
#pragma unroll
        for (int i = 0; i < 4; ++i) {
            const int c = tid + 512 * i, key = c >> 3;
            const long row = row_blk - 128 + key;
            const bool ok = (nb > 0) || (key >= 128);
            u32x4 kraw = (u32x4){0u, 0u, 0u, 0u}, vraw = (u32x4){0u, 0u, 0u, 0u};
            if (ok) { const bf16_t* p = QKV + (size_t)row * NQKV + 1024 + hk * 64 + dc * 8; kraw = *(const u32x4*)p; vraw = *(const u32x4*)(p + 128); }
            float kf[8];
            kf[0] = bf_lo(kraw.x); kf[1] = bf_hi(kraw.x); kf[2] = bf_lo(kraw.y); kf[3] = bf_hi(kraw.y); kf[4] = bf_lo(kraw.z); kf[5] = bf_hi(kraw.z); kf[6] = bf_lo(kraw.w); kf[7] = bf_hi(kraw.w);
            float ss = 0.f;
#pragma unroll
            for (int e = 0; e < 8; ++e) ss += kf[e] * kf[e];
            ss += __shfl_xor(ss, 1); ss += __shfl_xor(ss, 2); ss += __shfl_xor(ss, 4);
            const float rstd = 1.0f / sqrtf(ss * (1.f / 64.f) + EPS);
#pragma unroll
            for (int e = 0; e < 8; ++e) kf[e] = kf[e] * rstd * kgv[e];
            u32x4 kw; kw.x = cvtpk(kf[0], kf[1]); kw.y = cvtpk(kf[2], kf[3]); kw.z = cvtpk(kf[4], kf[5]); kw.w = cvtpk(kf[6], kf[7]);
            *(LAS u32x4*)(Ks + key * KS_STRIDE + dc * 16) = kw;
            LAS unsigned char* vp = Vt + (dc * 8) * VT_STRIDE + key * 2;
            *(LAS unsigned short*)(vp + 0 * VT_STRIDE) = (unsigned short)(vraw.x & 0xffffu); *(LAS unsigned short*)(vp + 1 * VT_STRIDE) = (unsigned short)(vraw.x >> 16);
            *(LAS unsigned short*)(vp + 2 * VT_STRIDE) = (unsigned short)(vraw.y & 0xffffu); *(LAS unsigned short*)(vp + 3 * VT_STRIDE) = (unsigned short)(vraw.y >> 16);
            *(LAS unsigned short*)(vp + 4 * VT_STRIDE) = (unsigned short)(vraw.z & 0xffffu); *(LAS unsigned short*)(vp + 5 * VT_STRIDE) = (unsigned short)(vraw.z >> 16);
            *(LAS unsigned short*)(vp + 6 * VT_STRIDE) = (unsigned short)(vraw.w & 0xffffu); *(LAS unsigned short*)(vp + 7 * VT_STRIDE) = (unsigned short)(vraw.w >> 16);
        }
        if (hk == 0) {
#pragma unroll 4
            for (int i = 0; i < 32; ++i) { const int idx = tid + 512 * i, r = idx >> 7, c8 = idx & 127;
                u32x4* lp = (u32x4*)(XL + xt_off((int)row_blk + r, 8 * c8)); const u32x4 lv = *lp; const f32x4 b0 = *((const f32x4*)bo + 2 * c8), b1 = *((const f32x4*)bo + 2 * c8 + 1); u32x4 ln;
                ln.x = cvtpk(bf_lo(lv.x) + b0.x, bf_hi(lv.x) + b0.y); ln.y = cvtpk(bf_lo(lv.y) + b0.z, bf_hi(lv.y) + b0.w);
                ln.z = cvtpk(bf_lo(lv.z) + b1.x, bf_hi(lv.z) + b1.y); ln.w = cvtpk(bf_lo(lv.w) + b1.z, bf_hi(lv.w) + b1.w);
                *lp = ln; }
        }
        __syncthreads();
        const int head = hk * 8 + wid;
        const float sink = sinks[head];
        const LAS float* bT = biasT + head * 128;
        for (int sb = 0; sb < 4; ++sb) {
            const long qrow = row_blk + sb * 32 + r32;
            const bf16_t* qp = QKV + (size_t)qrow * NQKV + head * 64 + hi * 8;
            u32x4 qraw[4];
#pragma unroll
            for (int ds = 0; ds < 4; ++ds) qraw[ds] = *(const u32x4*)(qp + ds * 16);
            float ss = 0.f;
#pragma unroll
            for (int ds = 0; ds < 4; ++ds) {
                const float a0 = bf_lo(qraw[ds].x), a1 = bf_hi(qraw[ds].x), a2 = bf_lo(qraw[ds].y), a3 = bf_hi(qraw[ds].y), a4 = bf_lo(qraw[ds].z), a5 = bf_hi(qraw[ds].z), a6 = bf_lo(qraw[ds].w), a7 = bf_hi(qraw[ds].w);
                ss += (a0 * a0 + a1 * a1) + (a2 * a2 + a3 * a3) + (a4 * a4 + a5 * a5) + (a6 * a6 + a7 * a7);
            }
            ss += __shfl_xor(ss, 32);
            const float qs = 0.125f / sqrtf(ss * (1.f / 64.f) + EPS);
            bf16x8 qf[4];
#pragma unroll
            for (int ds = 0; ds < 4; ++ds) {
                const f32x4 g0 = *(const f32x4*)(qg + ds * 16 + hi * 8), g1 = *(const f32x4*)(qg + ds * 16 + hi * 8 + 4);
                u32x4 w;
                w.x = cvtpk(bf_lo(qraw[ds].x) * qs * g0.x, bf_hi(qraw[ds].x) * qs * g0.y); w.y = cvtpk(bf_lo(qraw[ds].y) * qs * g0.z, bf_hi(qraw[ds].y) * qs * g0.w);
                w.z = cvtpk(bf_lo(qraw[ds].z) * qs * g1.x, bf_hi(qraw[ds].z) * qs * g1.y); w.w = cvtpk(bf_lo(qraw[ds].w) * qs * g1.z, bf_hi(qraw[ds].w) * qs * g1.w);
                qf[ds] = __builtin_bit_cast(bf16x8, w);
            }
            f32x16 S[5];
#pragma unroll
            for (int j = 0; j < 5; ++j) {
                f32x16 a = {};
#pragma unroll
                for (int ds = 0; ds < 4; ++ds) {
                    const bf16x8 kfr = *(const LAS bf16x8*)(Ks + (32 * (sb + j) + r32) * KS_STRIDE + ds * 32 + hi * 16);
                    a = __builtin_amdgcn_mfma_f32_32x32x16_bf16(kfr, qf[ds], a, 0, 0, 0);
                }
                S[j] = a;
            }
            const int qi = sb * 32 + r32;
            float mx = sink;
#pragma unroll
            for (int j = 0; j < 5; ++j)
#pragma unroll
                for (int i = 0; i < 16; ++i) {
                    const int ki = 32 * (sb + j) + crow(i, hi), dist = qi + 128 - ki;
                    const bool valid = (dist >= 0) && (dist < 128) && ((nb > 0) || (ki >= 128));
                    const float s = valid ? S[j][i] + bT[dist & 127] : -INFINITY;
                    S[j][i] = s; mx = fmaxf(mx, s);
                }
            mx = fmaxf(mx, __shfl_xor(mx, 32));
            float l = 0.f;
#pragma unroll
            for (int j = 0; j < 5; ++j)
#pragma unroll
                for (int i = 0; i < 16; ++i) { const float p = __expf(S[j][i] - mx); S[j][i] = p; l += p; }
            l += __shfl_xor(l, 32);
            l += __expf(sink - mx);
            f32x16 o0 = {}, o1 = {};
#pragma unroll
            for (int j = 0; j < 5; ++j)
#pragma unroll
                for (int s = 0; s < 2; ++s) {
                    u32x4 pw; pw.x = cvtpk(S[j][8 * s + 0], S[j][8 * s + 1]); pw.y = cvtpk(S[j][8 * s + 2], S[j][8 * s + 3]); pw.z = cvtpk(S[j][8 * s + 4], S[j][8 * s + 5]); pw.w = cvtpk(S[j][8 * s + 6], S[j][8 * s + 7]);
                    const bf16x8 pf = __builtin_bit_cast(bf16x8, pw);
                    const int keyoff = 32 * (sb + j) + 16 * s + 4 * hi;
                    const LAS unsigned char* v0 = Vt + r32 * VT_STRIDE + keyoff * 2;
                    const LAS unsigned char* v1 = v0 + 32 * VT_STRIDE;
                    const s16x4 a0 = *(const LAS s16x4*)v0, a1 = *(const LAS s16x4*)(v0 + 16);
                    const s16x4 b0 = *(const LAS s16x4*)v1, b1 = *(const LAS s16x4*)(v1 + 16);
                    const bf16x8 vf0 = __builtin_shufflevector(a0, a1, 0, 1, 2, 3, 4, 5, 6, 7), vf1 = __builtin_shufflevector(b0, b1, 0, 1, 2, 3, 4, 5, 6, 7);
                    o0 = __builtin_amdgcn_mfma_f32_32x32x16_bf16(vf0, pf, o0, 0, 0, 0);
                    o1 = __builtin_amdgcn_mfma_f32_32x32x16_bf16(vf1, pf, o1, 0, 0, 0);
                }
            const float inv = 1.0f / l;
            bf16_t* op = O + (size_t)qrow * D + head * 64 + 4 * hi;
#pragma unroll
            for (int i4 = 0; i4 < 4; ++i4) {
                u32x2 w0, w1;
                w0.x = cvtpk(o0[4 * i4 + 0] * inv, o0[4 * i4 + 1] * inv); w0.y = cvtpk(o0[4 * i4 + 2] * inv, o0[4 * i4 + 3] * inv);
                w1.x = cvtpk(o1[4 * i4 + 0] * inv, o1[4 * i4 + 1] * inv); w1.y = cvtpk(o1[4 * i4 + 2] * inv, o1[4 * i4 + 3] * inv);
                *(u32x2*)(op + 8 * i4) = w0; *(u32x2*)(op + 32 + 8 * i4) = w1;
            }
        }
        __syncthreads();
    }
}

#define XB_TMO      128
#define XB_XCNT(j)  (256  + 64 * (j))
#define XB_XSUB(j)  (1280 + 64 * (j))
#define XB_XGEN(j)  (2304 + 64 * (j))
#define XB_TOP      3328
#define XB_TOPGEN   3392
#define XCD_BAR_WORDS 3456
#define XB_SPIN_CAP (1u << 18)
__device__ __forceinline__ unsigned xb_ld(unsigned* p)              { return __hip_atomic_load(p, __ATOMIC_RELAXED, __HIP_MEMORY_SCOPE_AGENT); }
__device__ __forceinline__ unsigned xb_add(unsigned* p, unsigned v) { return __hip_atomic_fetch_add(p, v, __ATOMIC_RELAXED, __HIP_MEMORY_SCOPE_AGENT); }
__device__ __forceinline__ unsigned xb_xcc_id() { return (unsigned)__builtin_amdgcn_s_getreg((3 << 11) | 20) & 0xFu; }
#define XB_SPIN(cond, bar) do { unsigned _sp = 0; while (cond) { __builtin_amdgcn_s_sleep(1); \
    if ((++_sp & 255u) == 0u) { if (xb_ld(&(bar)[XB_TMO])) break; if (_sp > XB_SPIN_CAP) { atomicAdd(&(bar)[XB_TMO], 1u); break; } } } } while (0)
struct XcdBarrier { unsigned* bar; unsigned x; volatile LAS unsigned* st; };
__device__ __forceinline__ XcdBarrier xcd_barrier_post(unsigned* bar, volatile LAS unsigned* st) {
    XcdBarrier b; b.bar = bar; b.x = xb_xcc_id(); b.st = st;
    if (threadIdx.x == 0) (void)xb_add(&bar[XB_XCNT(b.x)], 1u);
    return b;
}
__device__ __forceinline__ void xcd_barrier_complete(unsigned* bar, unsigned x, unsigned& nloc, unsigned& nx) {
    const unsigned G = gridDim.x * gridDim.y * gridDim.z;
    unsigned sum, cnt, mine, sp = 0u;
    for (;;) {
        sum = 0u; cnt = 0u; mine = 0u;
#pragma unroll
        for (unsigned j = 0; j < 16; ++j) { const unsigned c = xb_ld(&bar[XB_XCNT(j)]); sum += c; cnt += (c > 0u) ? 1u : 0u; mine = (j == x) ? c : mine; }
        if (sum == G) break;
        __builtin_amdgcn_s_sleep(1);
        if ((++sp & 255u) == 0u) { if (xb_ld(&bar[XB_TMO])) break; if (sp > XB_SPIN_CAP) { atomicAdd(&bar[XB_TMO], 1u); break; } }
    }
    nloc = mine > 0u ? mine : 1u; nx = cnt > 0u ? cnt : 1u;
}
__device__ __forceinline__ void xcd_barrier(const XcdBarrier& b) {
    asm volatile("s_waitcnt vmcnt(0)" ::: "memory");
    __syncthreads();
    if (threadIdx.x == 0) {
        unsigned* bar = b.bar;
        __builtin_amdgcn_s_waitcnt(0);
        unsigned nloc = b.st[0], nx = b.st[1];
        if (nloc == 0u) { xcd_barrier_complete(bar, b.x, nloc, nx); b.st[0] = nloc; b.st[1] = nx; }
        const unsigned old = xb_add(&bar[XB_XSUB(b.x)], 1u);
        const unsigned gen = old / nloc;
        if (old + 1u == (gen + 1u) * nloc) {
            __builtin_amdgcn_fence(__ATOMIC_RELEASE, "agent");
            asm volatile("s_waitcnt vmcnt(0)" ::: "memory");
            const unsigned og = xb_add(&bar[XB_TOP], 1u);
            const unsigned tg = og / nx;
            if (og + 1u == (tg + 1u) * nx) xb_add(&bar[XB_TOPGEN], 1u);
            else XB_SPIN(xb_ld(&bar[XB_TOPGEN]) == tg, bar);
            __builtin_amdgcn_fence(__ATOMIC_ACQUIRE, "agent");
            xb_add(&bar[XB_XGEN(b.x)], 1u);
            asm volatile("s_waitcnt vmcnt(0)" ::: "memory");
        } else {
            XB_SPIN(xb_ld(&bar[XB_XGEN(b.x)]) == gen, bar);
            __builtin_amdgcn_fence(__ATOMIC_ACQUIRE, "agent");
            asm volatile("s_waitcnt vmcnt(0)" ::: "memory");
        }
    }
    __syncthreads();
}

struct Args { const float* in[22]; float* out; unsigned char* ws; int lo, hi; };
static_assert(sizeof(Args) == 22 * 8 + 8 + 8 + 8, "Args has no padding");

__global__ void __launch_bounds__(512, 2) mk_fwd(Args args) {
    extern __shared__ __attribute__((aligned(16))) unsigned char lds_raw[];
    LAS unsigned char* lds = (LAS unsigned char*)lds_raw;
    cg::grid_group grid = cg::this_grid();
    const int G = gridDim.x, bx = blockIdx.x;
    const int vcu = (G % 8 == 0) ? (bx % 8) * (G / 8) + bx / 8 : bx;
    const int NGW = G * 8;
    volatile LAS unsigned* MISC = (volatile LAS unsigned*)(lds + RING_BYTES + 1024);
    if (threadIdx.x == 0) { MISC[0] = 0u; MISC[1] = 0u; }
    __syncthreads();
    const bool one_launch = (args.hi - args.lo) > 1;
    XcdBarrier bar; bar.bar = (unsigned*)args.ws; bar.x = 0; bar.st = MISC;
    if (one_launch) bar = xcd_barrier_post((unsigned*)args.ws, MISC);

    for (int step = args.lo; step < args.hi; ++step) {
        int tid = threadIdx.x; asm volatile("" : "+v"(tid) :: "memory");
        const int lane = tid & 63, wave = __builtin_amdgcn_readfirstlane(tid >> 6), gw = vcu * 8 + wave;
        const int op = PROG[step][0], L = PROG[step][1], F = PROG[step][2];
        size_t zoff = 0; asm volatile("" : "+s"(zoff));
        unsigned char* ws = args.ws + zoff;
        float* xout = args.out + zoff;
        bf16_t* XL = (bf16_t*)(ws + WS_XL);
        bf16_t* XB = (bf16_t*)(ws + WS_H);
        float* SS = (float*)(ws + WS_SS);
        bf16_t* ACT = (bf16_t*)(ws + WS_ACT);
        bf16_t* WIN = (bf16_t*)(ws + WS_WIN);
        bf16_t* WOUT = (bf16_t*)(ws + WS_WOUT);
        bf16_t* CIN = (bf16_t*)(ws + WS_CIN);
        bf16_t* COUT = (bf16_t*)(ws + WS_COUT);
        bf16_t* POOLW = (bf16_t*)(ws + WS_POOL);
        bf16_t* WQKV = (bf16_t*)(ws + WS_WQKV);
        bf16_t* WO = (bf16_t*)(ws + WS_WO);
        bf16_t* CONV_U = ACT + (size_t)2 * M * D;
        bf16_t* ATT_O = ACT + (size_t)M * NQKV;

        if (op == OP_PROLOGUE) {
            LAS float* scr = (LAS float*)(lds + wave * 16384);
            constexpr int I_FI = (D / 64) * (2 * FF / 32), I_FO = (FF / 64) * (D / 32), I_CI = (D / 64) * (3 * D / 32), I_CO = (D / 64) * (D / 32), I_P = (256 / 64) * (256 / 32), I_Q = (D / 64) * (NQKV / 32);
            constexpr int NITEMS = 8 * I_FI + 8 * I_FO + 2 * I_CI + 2 * I_CO + 4 * I_P + I_Q + I_CO;
            for (int it = gw; it < NITEMS; it += NGW) {
                int r = it;
                if (r < 8 * I_FI) { const int idx = r / I_FI; r %= I_FI; const int l = idx >> 1, f = idx & 1;
                    transpose_item(args.in[f ? 6 : 2] + (size_t)l * WIN_STRIDE, D, 2 * FF, WIN + (size_t)idx * WIN_STRIDE, 1, args.in[f ? 5 : 1] + l * D, nullptr, 1.0f, scr, r, lane); continue; }
                r -= 8 * I_FI;
                if (r < 8 * I_FO) { const int idx = r / I_FO; r %= I_FO; const int l = idx >> 1, f = idx & 1;
                    transpose_item(args.in[f ? 7 : 3] + (size_t)l * WOUT_STRIDE, FF, D, WOUT + (size_t)idx * WOUT_STRIDE, 0, nullptr, nullptr, 0.5f, scr, r, lane); continue; }
                r -= 8 * I_FO;
                if (r < 2 * I_CI) { const int j = r / I_CI; r %= I_CI;
                    transpose_item(args.in[8] + (size_t)j * D * 3 * D, D, 3 * D, CIN + (size_t)j * 3 * D * D, 2, args.in[4] + (j ? 3 : 0) * D, nullptr, 1.0f, scr, r, lane); continue; }
                r -= 2 * I_CI;
                if (r < 2 * I_CO) { const int j = r / I_CO; r %= I_CO;
                    transpose_item(args.in[10] + (size_t)j * D * D, D, D, COUT + (size_t)j * D * D, 0, nullptr, nullptr, 1.0f, scr, r, lane); continue; }
                r -= 2 * I_CO;
                if (r < 4 * I_P) { const int gidx = r / I_P; r %= I_P;
                    transpose_item(args.in[11] + (size_t)gidx * 256 * 256, 256, 256, POOLW + (size_t)gidx * 256 * 256, 0, args.in[4] + 1 * D + gidx * 256, args.in[13] + gidx * 256, 1.0f, scr, r, lane); continue; }
                r -= 4 * I_P;
                if (r < I_Q) { transpose_item(args.in[14], D, NQKV, WQKV, 0, args.in[4] + 2 * D, nullptr, 1.0f, scr, r, lane); continue; }
                r -= I_Q;
                transpose_item(args.in[19], D, D, WO, 0, nullptr, nullptr, 1.0f, scr, r, lane);
            }
            if (gw == 0) { for (int i = lane; i < D; i += 64) ((float*)(ws + WS_PBIAS))[i] = args.in[12][i] * args.in[13][i]; }
            xb_rows(args.in[0], XL, XB, SS, gw, NGW, lane);
        } else if (op == OP_SWIGLU) {
            pg8::Gemm g{XB, WIN + (size_t)(L * 2 + F) * WIN_STRIDE, M, 2 * FF, D, D, 0, 1};
            pg8::StaticOrder S; S.init(M, 2 * FF, G, bx);
            pg8::EpiSwiglu E{ACT, FF, SS};
            pg8::gemm_phase<pg8::EpiSwiglu>(lds, g, S, E, tid);
        } else if (op == OP_RESID_FFN || op == OP_CONV_OUT || op == OP_POOL_GEMM || op == OP_WO) {
            const bf16_t* gA = ACT; const bf16_t* gB = POOLW; int gK = 256, glda = D, gpn = 256;
            if (op == OP_RESID_FFN) { gB = WOUT + (size_t)(L * 2 + F) * WOUT_STRIDE; gK = FF; glda = FF; gpn = 0; }
            else if (op == OP_CONV_OUT) { gA = CONV_U; gB = COUT + (size_t)F * D * D; gK = D; gpn = 0; }
            else if (op == OP_WO) { gA = ATT_O; gB = WO; gK = D; gpn = 0; }
            const pg8::Gemm g{gA, gB, M, D, gK, glda, gpn, (op == OP_RESID_FFN) ? 1 : 0};
            pg8::StaticOrder S; S.init(M, D, G, bx);
            if (step == NSTEPS - 1) { const pg8::EpiResid<true> E{xout, XB, XL, SS}; pg8::gemm_phase<pg8::EpiResid<true>>(lds, g, S, E, tid); }
            else { const pg8::EpiResid<false> E{nullptr, XB, XL, SS}; pg8::gemm_phase<pg8::EpiResid<false>>(lds, g, S, E, tid); }
        } else if (op == OP_CONV_IN) {
            pg8::Gemm g{XB, CIN + (size_t)F * 3 * D * D, M, 3 * D, D, D, 0, 1};
            pg8::StaticOrder S; S.init(M, 3 * D, G, bx);
            pg8::EpiConvIn E{ACT, ACT + (size_t)M * D, SS};
            pg8::gemm_phase<pg8::EpiConvIn>(lds, g, S, E, tid);
        } else if (op == OP_CONV_EW) {
            const bf16_t* Bb = ACT; const bf16_t* Z = ACT + (size_t)M * D; const float* cw = args.in[9] + (size_t)F * 3 * D;
            const int ch = tid & 127, rsub = tid >> 7;
            const f32x4 w0a = *(const f32x4*)(cw + ch * 8), w0b = *(const f32x4*)(cw + ch * 8 + 4);
            const f32x4 w1a = *(const f32x4*)(cw + D + ch * 8), w1b = *(const f32x4*)(cw + D + ch * 8 + 4);
            const f32x4 w2a = *(const f32x4*)(cw + 2 * D + ch * 8), w2b = *(const f32x4*)(cw + 2 * D + ch * 8 + 4);
            for (int grp = vcu; grp < M / 16; grp += G) {
                u32x4 z0[4], z1[4], z2[4], bb[4];
#pragma unroll
                for (int k = 0; k < 4; ++k) {
                    const int row = grp * 16 + k * 4 + rsub, t = row & (SEQ - 1);
                    const size_t off = (size_t)row * D + ch * 8;
                    z0[k] = *(const u32x4*)(Z + off);
                    z1[k] = (t >= 1) ? *(const u32x4*)(Z + off - D) : (u32x4){0u, 0u, 0u, 0u};
                    z2[k] = (t >= 2) ? *(const u32x4*)(Z + off - 2 * D) : (u32x4){0u, 0u, 0u, 0u};
                    bb[k] = *(const u32x4*)(Bb + off);
                }
#pragma unroll
                for (int k = 0; k < 4; ++k) {
                    const int row = grp * 16 + k * 4 + rsub;
                    const size_t off = (size_t)row * D + ch * 8;
                    float r[8];
#define CONV1(q, zz0, zz1, zz2, bbb, wa0, wa1, wa2) r[q] = (bbb) * ((wa0) * (zz2) + (wa1) * (zz1) + (wa2) * (zz0))
                    CONV1(0, bf_lo(z0[k].x), bf_lo(z1[k].x), bf_lo(z2[k].x), bf_lo(bb[k].x), w0a.x, w1a.x, w2a.x);
                    CONV1(1, bf_hi(z0[k].x), bf_hi(z1[k].x), bf_hi(z2[k].x), bf_hi(bb[k].x), w0a.y, w1a.y, w2a.y);
                    CONV1(2, bf_lo(z0[k].y), bf_lo(z1[k].y), bf_lo(z2[k].y), bf_lo(bb[k].y), w0a.z, w1a.z, w2a.z);
                    CONV1(3, bf_hi(z0[k].y), bf_hi(z1[k].y), bf_hi(z2[k].y), bf_hi(bb[k].y), w0a.w, w1a.w, w2a.w);
                    CONV1(4, bf_lo(z0[k].z), bf_lo(z1[k].z), bf_lo(z2[k].z), bf_lo(bb[k].z), w0b.x, w1b.x, w2b.x);
                    CONV1(5, bf_hi(z0[k].z), bf_hi(z1[k].z), bf_hi(z2[k].z), bf_hi(bb[k].z), w0b.y, w1b.y, w2b.y);
                    CONV1(6, bf_lo(z0[k].w), bf_lo(z1[k].w), bf_lo(z2[k].w), bf_lo(bb[k].w), w0b.z, w1b.z, w2b.z);
                    CONV1(7, bf_hi(z0[k].w), bf_hi(z1[k].w), bf_hi(z2[k].w), bf_hi(bb[k].w), w0b.w, w1b.w, w2b.w);
#undef CONV1
                    u32x4 w; w.x = cvtpk(r[0], r[1]); w.y = cvtpk(r[2], r[3]); w.z = cvtpk(r[4], r[5]); w.w = cvtpk(r[6], r[7]);
                    *(u32x4*)(CONV_U + off) = w;
                }
            }
        } else if (op == OP_POOL_DIFF) {
            LAS float* rsl = (LAS float*)lds;
            const float* pbias = (const float*)(ws + WS_PBIAS);
            for (int blk = vcu; blk < M / 64; blk += G) {
                const int row0 = blk * 64, t0 = row0 & (SEQ - 1);
                if (tid < 79) rsl[tid] = (t0 - 15 + tid >= 0) ? pg8::row_rstd(SS, row0 - 15 + tid) : 0.f;
                __syncthreads();
#define POOL_LOAD(X, IT) \
                    const int rl##X = ((tid + 512 * (IT)) >> 7), t##X = t0 + rl##X, cnt##X = (t##X + 1 < win) ? (t##X + 1) : win; \
                    const size_t off##X = (size_t)(row0 + rl##X) * D + ch * 8; \
                    const u32x4 h0##X = *(const u32x4*)(XB + xt_off(row0 + rl##X, ch * 8)); \
                    u32x4* lp##X = (u32x4*)(XL + xt_off(row0 + rl##X, ch * 8)); const u32x4 lv##X = *lp##X; \
                    u32x4 hv##X[15]; \
                    _Pragma("unroll") for (int i = 1; i < 16; ++i) hv##X[i - 1] = (i < cnt##X) ? *(const u32x4*)(XB + xt_off(row0 + rl##X - i, ch * 8)) : (u32x4){0u, 0u, 0u, 0u};
#define POOL_FINISH(X) { \
                    const float r0 = rsl[15 + rl##X]; float s[8], c0[8]; \
                    c0[0] = bf_lo(h0##X.x) * r0; c0[1] = bf_hi(h0##X.x) * r0; c0[2] = bf_lo(h0##X.y) * r0; c0[3] = bf_hi(h0##X.y) * r0; c0[4] = bf_lo(h0##X.z) * r0; c0[5] = bf_hi(h0##X.z) * r0; c0[6] = bf_lo(h0##X.w) * r0; c0[7] = bf_hi(h0##X.w) * r0; \
                    _Pragma("unroll") for (int e = 0; e < 8; ++e) s[e] = c0[e]; \
                    _Pragma("unroll") for (int i = 1; i < 16; ++i) { const float ri = (i < cnt##X) ? rsl[15 + rl##X - i] : 0.f; \
                        s[0] += bf_lo(hv##X[i - 1].x) * ri; s[1] += bf_hi(hv##X[i - 1].x) * ri; s[2] += bf_lo(hv##X[i - 1].y) * ri; s[3] += bf_hi(hv##X[i - 1].y) * ri; \
                        s[4] += bf_lo(hv##X[i - 1].z) * ri; s[5] += bf_hi(hv##X[i - 1].z) * ri; s[6] += bf_lo(hv##X[i - 1].w) * ri; s[7] += bf_hi(hv##X[i - 1].w) * ri; } \
                    const float ic = 1.0f / (float)cnt##X; \
                    u32x4 w; w.x = cvtpk(s[0] * ic - c0[0], s[1] * ic - c0[1]); w.y = cvtpk(s[2] * ic - c0[2], s[3] * ic - c0[3]); \
                    w.z = cvtpk(s[4] * ic - c0[4], s[5] * ic - c0[5]); w.w = cvtpk(s[6] * ic - c0[6], s[7] * ic - c0[7]); \
                    *(u32x4*)(ACT + off##X) = w; \
                    u32x4 ln;   \
                    ln.x = cvtpk(bf_lo(lv##X.x) + pb0.x, bf_hi(lv##X.x) + pb0.y); ln.y = cvtpk(bf_lo(lv##X.y) + pb0.z, bf_hi(lv##X.y) + pb0.w); \
                    ln.z = cvtpk(bf_lo(lv##X.z) + pb1.x, bf_hi(lv##X.z) + pb1.y); ln.w = cvtpk(bf_lo(lv##X.w) + pb1.z, bf_hi(lv##X.w) + pb1.w); \
                    *lp##X = ln; }
                const int ch = tid & 127, win = 2 << (ch >> 5);
                const f32x4 pb0 = *(const f32x4*)(pbias + ch * 8), pb1 = *(const f32x4*)(pbias + ch * 8 + 4);
#pragma unroll 1
                for (int it = 0; it < 16; it += 2) {
                    POOL_LOAD(A, it)
                    POOL_LOAD(B, it + 1)
                    POOL_FINISH(A)
                    POOL_FINISH(B)
                }
#undef POOL_LOAD
#undef POOL_FINISH
                __syncthreads();
            }
        } else if (op == OP_QKV) {
            pg8::Gemm g{XB, WQKV, M, NQKV, D, D, 0, 1};
            pg8::StaticOrder S; S.init(M, NQKV, G, bx);
            pg8::EpiBf16 E{ACT, NQKV, args.in[15], SS};
            pg8::gemm_phase<pg8::EpiBf16>(lds, g, S, E, tid);
        } else if (op == OP_ATTN) {
            attn_phase(lds, ACT, ATT_O, XL, args.in[20], args.in[16], args.in[17], args.in[18], args.in[21], vcu, G, tid);
        }
        if (step + 1 < args.hi) { if (step == args.lo) grid.sync(); else xcd_barrier(bar); }
    }
}

extern "C" void kernel_launch(void* const* d_in, const int* in_sizes, int n_in, void* d_out, int out_size, void* d_ws, size_t ws_size, hipStream_t stream) {
    static int grid = 0;
    if (grid == 0) {
        if (n_in != 22 || out_size != M * D || ws_size < WS_END) { fprintf(stderr, "kernel_launch: unexpected shapes n_in %d out %d ws %zu\n", n_in, out_size, ws_size); grid = -1; return; }
        int dev = 0, cus = 0, per_cu = 0;
        if (hipGetDevice(&dev) != hipSuccess || hipDeviceGetAttribute(&cus, hipDeviceAttributeMultiprocessorCount, dev) != hipSuccess) { grid = -1; return; }
        if (hipFuncSetAttribute((const void*)mk_fwd, hipFuncAttributeMaxDynamicSharedMemorySize, LDS_BYTES) != hipSuccess) { fprintf(stderr, "kernel_launch: hipFuncSetAttribute failed\n"); grid = -1; return; }
        if (hipOccupancyMaxActiveBlocksPerMultiprocessor(&per_cu, (const void*)mk_fwd, 512, LDS_BYTES) != hipSuccess || per_cu < 1) { fprintf(stderr, "kernel_launch: occupancy query says %d\n", per_cu); per_cu = 1; }
        (void)hipGetLastError();
        grid = cus * per_cu;
    }
    if (grid < 0) return;
    Args a{};
    for (int i = 0; i < 22; ++i) a.in[i] = (const float*)d_in[i];
    a.out = (float*)d_out; a.ws = (unsigned char*)d_ws;
#if MK_ONE_LAUNCH
    if (hipMemsetAsync(d_ws, 0, CTL_BYTES, stream) != hipSuccess) { fprintf(stderr, "kernel_launch: memset of control words failed\n"); return; }
    a.lo = 0; a.hi = NSTEPS;
    void* kargs[] = {&a};
    hipError_t e = hipLaunchCooperativeKernel((const void*)mk_fwd, dim3(grid), dim3(512), kargs, LDS_BYTES, stream);
    if (e != hipSuccess) fprintf(stderr, "cooperative launch failed: %s (grid %d)\n", hipGetErrorString(e), grid);
#else
    for (int s = 0; s < NSTEPS; ++s) {
        a.lo = s; a.hi = s + 1;
        hipLaunchKernelGGL(mk_fwd, dim3(grid), dim3(512), LDS_BYTES, stream, a);
    }
#endif
}
```

```cpp
#include <hip/hip_runtime.h>
#include <hip/hip_cooperative_groups.h>
#include <cstdio>
#include <cstdint>
namespace cg = cooperative_groups;

#ifndef MK_ONE_LAUNCH
#define MK_ONE_LAUNCH 1
#endif

#define LAS __attribute__((address_space(3)))
typedef unsigned short bf16_t;
typedef short bf16x8 __attribute__((ext_vector_type(8)));
typedef short s16x4 __attribute__((ext_vector_type(4)));
typedef float f32x4 __attribute__((ext_vector_type(4)));
typedef float f32x16 __attribute__((ext_vector_type(16)));
typedef unsigned u32x4 __attribute__((ext_vector_type(4)));
typedef unsigned u32x2 __attribute__((ext_vector_type(2)));
typedef float f32x2_t __attribute__((ext_vector_type(2)));
typedef __bf16 bf16x2_t __attribute__((ext_vector_type(2)));

constexpr int D = 1024, BATCH = 8, SEQ = 8192, M = BATCH * SEQ, DEPTH = 4, FF = 2816, NQKV = 1280;
constexpr float EPS = 1e-6f;

__device__ __forceinline__ unsigned cvtpk(float lo, float hi) { f32x2_t v = {lo, hi}; bf16x2_t b = __builtin_convertvector(v, bf16x2_t); return __builtin_bit_cast(unsigned, b); }
__device__ __forceinline__ size_t xt_off(int row, int col) { return ((size_t)(row >> 4) * 32 + (col >> 5)) * 512 + (row & 15) * 32 + (col & 31); }
__device__ __forceinline__ float bf_lo(unsigned u) { return __uint_as_float(u << 16); }
__device__ __forceinline__ float bf_hi(unsigned u) { return __uint_as_float(u & 0xffff0000u); }

namespace pg8 {
constexpr int BM = 256, BK = 64, HALF = 128, HTB = HALF * BK * 2, STAGE_BYTES = 8 * HTB, NXCD = 8, WGM = 8;
constexpr int EPI_STG_OFF = 131072 + 2048, EPI_STG_BYTES = 16 * 144;
__host__ __device__ __forceinline__ int lds_byte(int r, int c) { const int st = (r >> 4) * 2 + (c >> 5), rr = r & 15, cc = c & 31, ob = rr * 64 + cc * 2; return st * 1024 + (ob ^ (((ob >> 9) & 1) << 5)); }
__host__ __device__ __forceinline__ void stage_rc(int b, int& R, int& C) { const int st = b / 1024, sb = b % 1024, swz = sb ^ (((sb >> 9) & 1) << 5); R = (st >> 1) * 16 + swz / 64; C = (st & 1) * 32 + (swz % 64) / 2; }
__host__ __device__ __forceinline__ int perm32(int rho) { const int n = rho >> 4, i = rho & 15; return 8 * (i >> 2) + 4 * n + (i & 3); }

struct Unit { int pm, pn; };
struct Gemm { const bf16_t* A; const bf16_t* Bt; int M, N, K, lda, a_pn_off, a_tiled; };

struct StaticOrder {
    int nM, nN, nwg, G, c;
    __host__ __device__ void init(int M_, int N_, int G_, int c_) { nM = M_ / BM; nN = N_ / BM; nwg = nM * nN; G = G_; c = c_; }
    __host__ __device__ bool next(int i, Unit& u) const {
        const long L = (long)i * G + c; if (L >= nwg) return false;
        int wgid = (int)L; { const int q = nwg / NXCD, r = nwg % NXCD, xcd = wgid % NXCD, off = wgid / NXCD; wgid = (xcd < r ? xcd * (q + 1) : r * (q + 1) + (xcd - r) * q) + off; }
        const int nig = WGM * nN, gid = wgid / nig, fm = gid * WGM, gsz = (nM - fm) < WGM ? (nM - fm) : WGM;
        u.pm = fm + ((wgid % nig) % gsz); u.pn = (wgid % nig) / gsz; return true;
    }
};

typedef f32x4 AccT[2][2][4][2];

__device__ __forceinline__ f32x4 gload16(const void* p) { f32x4 v; asm volatile("global_load_dwordx4 %0, %1, off" : "=v"(v) : "v"(p) : "memory"); return v; }
__device__ __forceinline__ f32x4 gload16_nt(const void* p) { f32x4 v; asm volatile("global_load_dwordx4 %0, %1, off nt" : "=v"(v) : "v"(p) : "memory"); return v; }
#define WAIT8(a) asm volatile("s_waitcnt vmcnt(0)" : "+v"(a[0]), "+v"(a[1]), "+v"(a[2]), "+v"(a[3]), "+v"(a[4]), "+v"(a[5]), "+v"(a[6]), "+v"(a[7]) :: "memory")
#define WAIT16(a) asm volatile("s_waitcnt vmcnt(0)" : "+v"(a[0]), "+v"(a[1]), "+v"(a[2]), "+v"(a[3]), "+v"(a[4]), "+v"(a[5]), "+v"(a[6]), "+v"(a[7]), "+v"(a[8]), "+v"(a[9]), "+v"(a[10]), "+v"(a[11]), "+v"(a[12]), "+v"(a[13]), "+v"(a[14]), "+v"(a[15]) :: "memory")
__device__ __forceinline__ float row_rstd(const float* SS, int row) {
    const f32x4* p = (const f32x4*)(SS + (size_t)row * 16);
    const f32x4 a = p[0], b = p[1], c = p[2], d = p[3];
    const f32x4 s = (a + b) + (c + d);
    return 1.0f / sqrtf(((s.x + s.y) + (s.z + s.w)) * (1.f / D) + EPS);
}
__device__ __forceinline__ void rows_rstd(const float* SS, int row0, int fq, float (&rs)[2][4]) {
    f32x4 p[8];
#pragma unroll
    for (int i = 0; i < 8; ++i) p[i] = gload16(SS + (size_t)(row0 + (i >> 2) * HALF + (i & 3) * 16) * 16 + fq * 4);
    WAIT8(p);
#pragma unroll
    for (int i = 0; i < 8; ++i) {
        float s = (p[i].x + p[i].y) + (p[i].z + p[i].w);
        s += __shfl_xor(s, 16); s += __shfl_xor(s, 32);
        rs[i >> 2][i & 3] = __builtin_amdgcn_rsqf(s * (1.f / D) + EPS);
    }
}
__device__ __forceinline__ void rows_rstd_issue(const float* SS, int row0, int fq, f32x4 (&p)[8]) {
#pragma unroll
    for (int i = 0; i < 8; ++i) p[i] = gload16(SS + (size_t)(row0 + (i >> 2) * HALF + (i & 3) * 16) * 16 + fq * 4);
}
__device__ __forceinline__ void rows_rstd_finish(f32x4 (&p)[8], float (&rs)[2][4]) {
    WAIT8(p);
#pragma unroll
    for (int i = 0; i < 8; ++i) {
        float s = (p[i].x + p[i].y) + (p[i].z + p[i].w);
        s += __shfl_xor(s, 16); s += __shfl_xor(s, 32);
        rs[i >> 2][i & 3] = __builtin_amdgcn_rsqf(s * (1.f / D) + EPS);
    }
}
struct EpiSwiglu {
    static constexpr bool WIDE = false, NEXT_RS = false;
    bf16_t* O; int ldo; const float* SS;
    __device__ __forceinline__ void operator()(const AccT& acc, const Unit& u, int wr, int wc, int fr, int fq, LAS unsigned char* stg) const {
        const int row0 = u.pm * BM + wr * 64 + fr;
        float rs[2][4];
        rows_rstd(SS, row0, fq, rs);
#pragma unroll
        for (int ai = 0; ai < 2; ++ai)
#pragma unroll
            for (int m = 0; m < 4; ++m) {
                bf16_t* rowp = O + ((size_t)(u.pm * 16 + wr * 4 + ai * 8 + m) * (ldo >> 5) + (u.pn * 4 + wc)) * 512 + fr * 32 + 8 * fq;
                const float k1 = rs[ai][m] * -1.4426950408889634f, k2 = rs[ai][m] * rs[ai][m];
                float r[8];
#pragma unroll
                for (int n = 0; n < 2; ++n)
#pragma unroll
                    for (int i = 0; i < 4; ++i) {
                        const float g = acc[ai][0][m][n][i], up = acc[ai][1][m][n][i];
                        const float e = __builtin_amdgcn_exp2f(g * k1);
                        r[n * 4 + i] = (g * up) * (k2 * __builtin_amdgcn_rcpf(1.0f + e));
                    }
                u32x4 w; w.x = cvtpk(r[0], r[1]); w.y = cvtpk(r[2], r[3]); w.z = cvtpk(r[4], r[5]); w.w = cvtpk(r[6], r[7]);
                __builtin_nontemporal_store(w, (u32x4*)rowp);
            }
    }
};
template <bool LAST> struct EpiResid {
    static constexpr bool WIDE = true, NEXT_RS = false;
    float* fout; bf16_t* XB; bf16_t* XL; float* SS;
    __device__ __forceinline__ void operator()(const AccT& acc, const Unit& u, int wr, int wc, int fr, int fq, LAS unsigned char* stg) const {
        const int row0 = u.pm * BM + wr * 64 + fr, col0 = u.pn * BM + wc * 64 + 8 * fq;
        const size_t blk0 = ((size_t)(u.pm * 16 + wr * 4) * 32 + (u.pn * 8 + wc * 2)) * 512 + fr * 32 + 8 * fq;
        constexpr bool last = LAST;
#pragma unroll
        for (int ai = 0; ai < 2; ++ai) {
            f32x4 pre[16];
#pragma unroll
            for (int m = 0; m < 4; ++m) {
                const size_t boff = blk0 + (size_t)(ai * 8 + m) * (32 * 512);
                pre[m * 4 + 0] = gload16_nt(XB + boff); pre[m * 4 + 1] = gload16_nt(XB + boff + 512); pre[m * 4 + 2] = gload16_nt(XL + boff); pre[m * 4 + 3] = gload16_nt(XL + boff + 512);
            }
            WAIT16(pre);
#pragma unroll
            for (int m = 0; m < 4; ++m) {
                const size_t boff = blk0 + (size_t)(ai * 8 + m) * (32 * 512);
                const size_t off = (size_t)(row0 + ai * HALF + m * 16) * D + col0;
                float ssq = 0.f;
#pragma unroll
                for (int bj = 0; bj < 2; ++bj) {
                    const u32x4 hi = __builtin_bit_cast(u32x4, pre[m * 4 + bj]), lo = __builtin_bit_cast(u32x4, pre[m * 4 + 2 + bj]);
                    f32x4 o0, o1;
                    o0.x = bf_lo(hi.x) + bf_lo(lo.x); o0.y = bf_hi(hi.x) + bf_hi(lo.x); o0.z = bf_lo(hi.y) + bf_lo(lo.y); o0.w = bf_hi(hi.y) + bf_hi(lo.y);
                    o1.x = bf_lo(hi.z) + bf_lo(lo.z); o1.y = bf_hi(hi.z) + bf_hi(lo.z); o1.z = bf_lo(hi.w) + bf_lo(lo.w); o1.w = bf_hi(hi.w) + bf_hi(lo.w);
                    o0 += acc[ai][bj][m][0]; o1 += acc[ai][bj][m][1];
                    if constexpr (last) { *(f32x4*)(fout + off + bj * 32) = o0; *(f32x4*)(fout + off + bj * 32 + 4) = o1; }
                    else {
                        ssq += (o0.x * o0.x + o0.y * o0.y) + (o0.z * o0.z + o0.w * o0.w) + (o1.x * o1.x + o1.y * o1.y) + (o1.z * o1.z + o1.w * o1.w);
                        u32x4 w; w.x = cvtpk(o0.x, o0.y); w.y = cvtpk(o0.z, o0.w); w.z = cvtpk(o1.x, o1.y); w.w = cvtpk(o1.z, o1.w);
                        *(u32x4*)(XB + boff + bj * 512) = w;
                        u32x4 l;
                        l.x = cvtpk(o0.x - bf_lo(w.x), o0.y - bf_hi(w.x)); l.y = cvtpk(o0.z - bf_lo(w.y), o0.w - bf_hi(w.y));
                        l.z = cvtpk(o1.x - bf_lo(w.z), o1.y - bf_hi(w.z)); l.w = cvtpk(o1.z - bf_lo(w.w), o1.w - bf_hi(w.w));
                        __builtin_nontemporal_store(l, (u32x4*)(XL + boff + bj * 512));
                    }
                }
                if constexpr (!last) {
                    ssq += __shfl_xor(ssq, 16); ssq += __shfl_xor(ssq, 32);
                    if (fq == 0) SS[(size_t)(row0 + ai * HALF + m * 16) * 16 + u.pn * 4 + wc] = ssq;
                }
            }
        }
    }
};
struct EpiBf16 {
    static constexpr bool WIDE = false, NEXT_RS = false;
    bf16_t* O; int ldo; const float* bias; const float* SS;
    __device__ __forceinline__ void operator()(const AccT& acc, const Unit& u, int wr, int wc, int fr, int fq, LAS unsigned char* stg) const {
        const int row0 = u.pm * BM + wr * 64 + fr, col0 = u.pn * BM + wc * 32 + 8 * fq;
        f32x4 bv[2][2];
#pragma unroll
        for (int bj = 0; bj < 2; ++bj)
#pragma unroll
            for (int n = 0; n < 2; ++n) bv[bj][n] = *(const f32x4*)(bias + col0 + bj * HALF + 4 * n);
        float rsv[2][4];
        rows_rstd(SS, row0, fq, rsv);
#pragma unroll
        for (int ai = 0; ai < 2; ++ai)
#pragma unroll
            for (int m = 0; m < 4; ++m) {
                bf16_t* rowp = O + (size_t)(row0 + ai * HALF + m * 16) * ldo + col0;
                const float rs = rsv[ai][m];
#pragma unroll
                for (int bj = 0; bj < 2; ++bj) {
                    const f32x4 v0 = acc[ai][bj][m][0] * rs + bv[bj][0], v1 = acc[ai][bj][m][1] * rs + bv[bj][1];
                    u32x4 w; w.x = cvtpk(v0[0], v0[1]); w.y = cvtpk(v0[2], v0[3]); w.z = cvtpk(v1[0], v1[1]); w.w = cvtpk(v1[2], v1[3]);
                    *(u32x4*)(rowp + bj * HALF) = w;
                }
            }
    }
};
struct EpiConvIn {
    static constexpr bool WIDE = false, NEXT_RS = false;
    bf16_t* Bb; bf16_t* Z; const float* SS;
    __device__ __forceinline__ void operator()(const AccT& acc, const Unit& u, int wr, int wc, int fr, int fq, LAS unsigned char* stg) const {
        const int row0 = u.pm * BM + wr * 64 + fr;
        float rsv[2][4];
        rows_rstd(SS, row0, fq, rsv);
        if (u.pn < 4) {
            const int col0 = u.pn * BM + wc * 32 + 8 * fq;
#pragma unroll
            for (int ai = 0; ai < 2; ++ai)
#pragma unroll
                for (int m = 0; m < 4; ++m) {
                    bf16_t* rowp = Bb + (size_t)(row0 + ai * HALF + m * 16) * D + col0;
                    const float rs = rsv[ai][m];
#pragma unroll
                    for (int bj = 0; bj < 2; ++bj) {
                        const f32x4 v0 = acc[ai][bj][m][0] * rs, v1 = acc[ai][bj][m][1] * rs;
                        u32x4 w; w.x = cvtpk(v0[0], v0[1]); w.y = cvtpk(v0[2], v0[3]); w.z = cvtpk(v1[0], v1[1]); w.w = cvtpk(v1[2], v1[3]);
                        *(u32x4*)(rowp + bj * HALF) = w;
                    }
                }
        } else {
            const int col0 = (u.pn - 4) * HALF + wc * 32 + 8 * fq;
#pragma unroll
            for (int ai = 0; ai < 2; ++ai)
#pragma unroll
                for (int m = 0; m < 4; ++m) {
                    bf16_t* rowp = Z + (size_t)(row0 + ai * HALF + m * 16) * D + col0;
                    const float rs = rsv[ai][m], rs2 = rs * rs;
                    const f32x4 v0 = acc[ai][0][m][0] * acc[ai][1][m][0] * rs2, v1 = acc[ai][0][m][1] * acc[ai][1][m][1] * rs2;
                    u32x4 w; w.x = cvtpk(v0[0], v0[1]); w.y = cvtpk(v0[2], v0[3]); w.z = cvtpk(v1[0], v1[1]); w.w = cvtpk(v1[2], v1[3]);
                    *(u32x4*)rowp = w;
                }
        }
    }
};

template <class Epi>
__device__ __forceinline__ void gemm_phase(LAS unsigned char* lds, const Gemm g, const StaticOrder& S, const Epi& E, const int tid) {
    const int wid = __builtin_amdgcn_readfirstlane(tid >> 6), lane = tid & 63, wr = wid >> 2, wc = wid & 3, fr = lane & 15, fq = lane >> 4;
    const int K = g.K, nt = K / BK, lda = g.lda;
    unsigned voffA[2], voffB[2];
#pragma unroll
    for (int i = 0; i < 2; ++i) { int R, C; stage_rc(tid * 16 + i * 8192, R, C); const int Rb = R;
        voffA[i] = g.a_tiled ? (unsigned)(((R >> 4) * (lda >> 5) + (C >> 5)) * 512 + (R & 15) * 32 + (C & 31)) * 2u : (unsigned)(R * lda + C) * 2u; voffB[i] = (unsigned)(((Rb >> 4) * (K >> 5) + (C >> 5)) * 512 + (Rb & 15) * 32 + (C & 31)) * 2u; }
    const size_t kstep = (size_t)(BK * 2), kstepA = g.a_tiled ? (size_t)2048 : kstep;
    const size_t hstepA = (size_t)HALF * lda * 2, tstepA = 2 * hstepA;
    const size_t hstepB = (size_t)HALF * K * 2, tstepB = (size_t)BM * K * 2, kstepB = 2048;
    const size_t pnoffA = (size_t)g.a_pn_off * 2;
    const unsigned ldsw = (unsigned)wid * 1024u;
    const int aoff = lds_byte(wr * 64 + fr, fq * 8), boff = lds_byte(wc * 32 + fr, fq * 8);
#define PG8_SA(b, h) (((b) * 2 + (h)) * HTB)
#define PG8_SB(b, h) ((4 + (b) * 2 + (h)) * HTB)
#define PG8_STAGE(bufoff, gbase, voff) do { _Pragma("unroll") for (int _i = 0; _i < 2; ++_i) \
        __builtin_amdgcn_global_load_lds((const unsigned*)((const char*)(gbase) + (voff)[_i]), (LAS unsigned*)(lds + (bufoff) + ldsw + _i * 8192), 16, 0, 0); } while (0)
#define PG8_LDA(dst, b, h) do { _Pragma("unroll") for (int m = 0; m < 4; ++m) _Pragma("unroll") for (int k = 0; k < 2; ++k) dst[m][k] = *(const LAS bf16x8*)(lds + PG8_SA(b, h) + aoff + m * 2048 + k * 1024); } while (0)
#define PG8_LDB(dst, b, h) do { _Pragma("unroll") for (int n = 0; n < 2; ++n) _Pragma("unroll") for (int k = 0; k < 2; ++k) dst[n][k] = *(const LAS bf16x8*)(lds + PG8_SB(b, h) + boff + n * 2048 + k * 1024); } while (0)
#define PG8_MMA(ai, bj, At, Bt) do { __builtin_amdgcn_s_setprio(1); _Pragma("unroll") for (int m = 0; m < 4; ++m) _Pragma("unroll") for (int n = 0; n < 2; ++n) _Pragma("unroll") for (int k = 0; k < 2; ++k) \
        acc[ai][bj][m][n] = __builtin_amdgcn_mfma_f32_16x16x32_bf16(Bt[n][k], At[m][k], acc[ai][bj][m][n], 0, 0, 0); __builtin_amdgcn_s_setprio(0); } while (0)
#define PG8_WAIT_V(n) asm volatile("s_waitcnt vmcnt(" #n ")" ::: "memory")
#define PG8_WAIT_L(n) asm volatile("s_waitcnt lgkmcnt(" #n ")" ::: "memory")
#define PG8_BAR __builtin_amdgcn_s_barrier()
#define PG8_SCHED __builtin_amdgcn_sched_barrier(0)
    Unit cur, nxt; int ui = 0;
    if (!S.next(0, cur)) return;
    float rs[2][4];
    if constexpr (Epi::NEXT_RS) rows_rstd(E.SS, cur.pm * BM + wr * 64 + fr, fq, rs);
    f32x4 acc[2][2][4][2];
#pragma unroll
    for (int a = 0; a < 2; ++a)
#pragma unroll
        for (int b = 0; b < 2; ++b)
#pragma unroll
            for (int m = 0; m < 4; ++m)
#pragma unroll
                for (int n = 0; n < 2; ++n) acc[a][b][m][n] = (f32x4){0.f, 0.f, 0.f, 0.f};
    bf16x8 At[4][2], B0[2][2], B1[2][2];
    const char* cA = (const char*)g.A + (size_t)cur.pm * tstepA + (size_t)cur.pn * pnoffA; const char* cB = (const char*)g.Bt + (size_t)cur.pn * tstepB;
    PG8_STAGE(PG8_SB(0, 0), cB, voffB); PG8_STAGE(PG8_SB(0, 1), cB + hstepB, voffB); PG8_STAGE(PG8_SA(0, 0), cA, voffA); PG8_STAGE(PG8_SA(0, 1), cA + hstepA, voffA);
    if (wr == 1) PG8_BAR;
    PG8_WAIT_V(2); PG8_BAR;
    PG8_STAGE(PG8_SB(1, 0), cB + kstepB, voffB); PG8_STAGE(PG8_SA(1, 0), cA + kstepA, voffA); PG8_STAGE(PG8_SB(1, 1), cB + hstepB + kstepB, voffB);
    PG8_WAIT_V(6); PG8_BAR;
    for (;;) {
        const bool has_next = S.next(ui + 1, nxt);
        const char* nA = has_next ? (const char*)g.A + (size_t)nxt.pm * tstepA + (size_t)nxt.pn * pnoffA : cA; const char* nB = has_next ? (const char*)g.Bt + (size_t)nxt.pn * tstepB : cB;
        for (int t = 0; t < nt; t += 2) {
            const bool last = (t == nt - 2);
            const char* a1 = cA + (size_t)(t + 1) * kstepA;
            const char* a2 = last ? nA : cA + (size_t)(t + 2) * kstepA; const char* b2 = last ? nB : cB + (size_t)(t + 2) * kstepB;
            const char* a3 = a2 + kstepA; const char* b3 = b2 + kstepB;
            PG8_LDB(B0, 0, 0); PG8_LDB(B1, 0, 1); PG8_SCHED; PG8_LDA(At, 0, 0); PG8_STAGE(PG8_SA(1, 1), a1 + hstepA, voffA);
            PG8_WAIT_V(8); PG8_WAIT_L(0); PG8_BAR; PG8_MMA(0, 0, At, B0); PG8_MMA(0, 1, At, B1); PG8_BAR; PG8_SCHED;
            PG8_LDA(At, 0, 1); PG8_STAGE(PG8_SB(0, 0), b2, voffB); PG8_STAGE(PG8_SB(0, 1), b2 + hstepB, voffB); PG8_STAGE(PG8_SA(0, 0), a2, voffA);
            PG8_WAIT_V(8); PG8_WAIT_L(0); PG8_BAR; PG8_MMA(1, 0, At, B0); PG8_MMA(1, 1, At, B1); PG8_BAR; PG8_SCHED;
            PG8_LDB(B0, 1, 0); PG8_LDB(B1, 1, 1); PG8_SCHED; PG8_LDA(At, 1, 0); PG8_STAGE(PG8_SA(0, 1), a2 + hstepA, voffA);
            PG8_WAIT_V(8); PG8_WAIT_L(0); PG8_BAR; PG8_MMA(0, 0, At, B0); PG8_MMA(0, 1, At, B1); PG8_BAR; PG8_SCHED;
            PG8_LDA(At, 1, 1); PG8_STAGE(PG8_SB(1, 0), b3, voffB); PG8_STAGE(PG8_SB(1, 1), b3 + hstepB, voffB); PG8_STAGE(PG8_SA(1, 0), a3, voffA);
            PG8_WAIT_V(8); PG8_WAIT_L(0); PG8_BAR; PG8_MMA(1, 0, At, B0); PG8_MMA(1, 1, At, B1); PG8_BAR; PG8_SCHED;
        }
        if (wr == 0) PG8_BAR;
        if constexpr (Epi::NEXT_RS) E(acc, cur, wr, wc, fr, fq, lds + EPI_STG_OFF + wid * EPI_STG_BYTES, rs, has_next ? nxt.pm : cur.pm);
        else E(acc, cur, wr, wc, fr, fq, lds + EPI_STG_OFF + wid * EPI_STG_BYTES);
        if (!has_next) break;
#pragma unroll
        for (int a = 0; a < 2; ++a)
#pragma unroll
            for (int b = 0; b < 2; ++b)
#pragma unroll
                for (int m = 0; m < 4; ++m)
#pragma unroll
                    for (int n = 0; n < 2; ++n) acc[a][b][m][n] = (f32x4){0.f, 0.f, 0.f, 0.f};
        cur = nxt; cA = nA; cB = nB; ++ui;
        if (wr == 1) PG8_BAR;
    }
    PG8_WAIT_V(0);
    PG8_BAR;
#undef PG8_SA
#undef PG8_SB
#undef PG8_STAGE
#undef PG8_LDA
#undef PG8_LDB
#undef PG8_MMA
#undef PG8_WAIT_V
#undef PG8_WAIT_L
#undef PG8_BAR
#undef PG8_SCHED
}
}

constexpr size_t MiB = 1u << 20;
constexpr size_t WS_WIN = 2 * MiB;
constexpr size_t WS_WOUT = WS_WIN + 88 * MiB;
constexpr size_t WS_CIN = WS_WOUT + 44 * MiB;
constexpr size_t WS_COUT = WS_CIN + 12 * MiB;
constexpr size_t WS_POOL = WS_COUT + 4 * MiB;
constexpr size_t WS_WQKV = WS_POOL + 1 * MiB;
constexpr size_t WS_WO = WS_WQKV + 3 * MiB;
constexpr size_t WS_SS = 156 * MiB;
constexpr size_t WS_H = 160 * MiB;
constexpr size_t WS_ACT = 288 * MiB;
constexpr size_t WS_XL = 672 * MiB;
constexpr size_t WS_END = 800 * MiB;
constexpr size_t WS_ZEROS = 1 * MiB, WS_PBIAS = 1 * MiB + 4096;
constexpr size_t CTL_BYTES = 65536;
static_assert(WS_WO + 2 * MiB <= WS_SS, "ws map");
constexpr size_t WIN_STRIDE = (size_t)2 * FF * D;
constexpr size_t WOUT_STRIDE = (size_t)D * FF;

constexpr int RING_BYTES = 131072, LDS_BYTES = 155648;
static_assert(pg8::EPI_STG_OFF + 8 * pg8::EPI_STG_BYTES <= LDS_BYTES, "LDS map");

enum Op { OP_PROLOGUE = 0, OP_SWIGLU, OP_RESID_FFN, OP_CONV_IN, OP_CONV_EW, OP_CONV_OUT, OP_POOL_DIFF, OP_POOL_GEMM, OP_QKV, OP_ATTN, OP_WO };
constexpr int NSTEPS = 28;
__device__ const unsigned char PROG[NSTEPS][3] = {
    {OP_PROLOGUE, 0, 0},
    {OP_SWIGLU, 0, 0}, {OP_RESID_FFN, 0, 0}, {OP_CONV_IN, 0, 0}, {OP_CONV_EW, 0, 0}, {OP_CONV_OUT, 0, 0}, {OP_SWIGLU, 0, 1}, {OP_RESID_FFN, 0, 1},
    {OP_SWIGLU, 1, 0}, {OP_RESID_FFN, 1, 0}, {OP_POOL_DIFF, 1, 0}, {OP_POOL_GEMM, 1, 0}, {OP_SWIGLU, 1, 1}, {OP_RESID_FFN, 1, 1},
    {OP_SWIGLU, 2, 0}, {OP_RESID_FFN, 2, 0}, {OP_QKV, 2, 0}, {OP_ATTN, 2, 0}, {OP_WO, 2, 0}, {OP_SWIGLU, 2, 1}, {OP_RESID_FFN, 2, 1},
    {OP_SWIGLU, 3, 0}, {OP_RESID_FFN, 3, 0}, {OP_CONV_IN, 3, 1}, {OP_CONV_EW, 3, 1}, {OP_CONV_OUT, 3, 1}, {OP_SWIGLU, 3, 1}, {OP_RESID_FFN, 3, 1},
};
__device__ const unsigned char BUCKET[128] = {0, 1, 2, 3, 4, 5, 6, 7, 8, 9, 10, 11, 12, 13, 14, 15, 16, 16, 16, 17, 17, 18, 18, 18, 19, 19, 19, 20, 20, 20, 20, 21, 21, 21, 21, 22, 22, 22, 22, 22, 23, 23, 23, 23, 23, 23, 24, 24, 24, 24, 24, 24, 25, 25, 25, 25, 25, 25, 25, 26, 26, 26, 26, 26, 26, 26, 26, 27, 27, 27, 27, 27, 27, 27, 27, 27, 27, 28, 28, 28, 28, 28, 28, 28, 28, 28, 28, 29, 29, 29, 29, 29, 29, 29, 29, 29, 29, 29, 29, 30, 30, 30, 30, 30, 30, 30, 30, 30, 30, 30, 30, 30, 30, 31, 31, 31, 31, 31, 31, 31, 31, 31, 31, 31, 31, 31, 31, 31};

__device__ __forceinline__ float wave_sum(float v) {
#pragma unroll
    for (int o = 1; o < 64; o <<= 1) v += __shfl_xor(v, o);
    return v;
}
__device__ __forceinline__ void transpose_item(const float* W, int K, int N, bf16_t* WT, int modew, const float* gain, const float* nscale, float cmul, LAS float* scr, int item, int lane) {
    const int mode = modew & 15, wide = modew >> 4;
    const int nblk = N / 32, kb = item / nblk, nb = item % nblk, k0 = 64 * kb, n0 = 32 * nb;
    int row0 = n0;
    if (mode == 1) { const int s = n0 / FF, j = n0 % FF; row0 = 256 * (j / 128) + 128 * s + (j % 128); }
    else if (mode == 2) { if (n0 >= D) { const int c = n0 - D, s = c / D, j = c % D; row0 = D + 256 * (j / 128) + 128 * s + (j % 128); } }
    { const int ks = lane >> 3, n4 = (lane & 7) * 4;
        f32x4 v[8];
#pragma unroll
        for (int i = 0; i < 8; ++i) v[i] = __builtin_nontemporal_load((const f32x4*)(W + (size_t)(k0 + 8 * i + ks) * N + n0 + n4));
#pragma unroll
        for (int i = 0; i < 8; ++i) { LAS float* d = scr + (8 * i + ks) * 33 + n4; d[0] = v[i].x; d[1] = v[i].y; d[2] = v[i].z; d[3] = v[i].w; } }
    asm volatile("s_waitcnt lgkmcnt(0)" ::: "memory");
    const int c = lane & 7;
    f32x4 ga0 = (f32x4){1.f, 1.f, 1.f, 1.f}, gb0 = ga0;
    if (gain) { ga0 = *(const f32x4*)(gain + k0 + 8 * c); gb0 = *(const f32x4*)(gain + k0 + 8 * c + 4); }
#pragma unroll
    for (int j = 0; j < 4; ++j) { const int n = (lane >> 3) + 8 * j; const LAS float* s = scr + (8 * c) * 33 + n;
        const float cs = nscale ? nscale[n0 + n] * cmul : cmul; const f32x4 ga = ga0 * cs, gb = gb0 * cs;
        u32x4 o; o.x = cvtpk(s[0 * 33] * ga.x, s[1 * 33] * ga.y); o.y = cvtpk(s[2 * 33] * ga.z, s[3 * 33] * ga.w); o.z = cvtpk(s[4 * 33] * gb.x, s[5 * 33] * gb.y); o.w = cvtpk(s[6 * 33] * gb.z, s[7 * 33] * gb.w);
        const int fr_ = row0 + n, T = fr_ >> 8, r = fr_ & 255, j5 = r & 31, ip = 16 * ((j5 >> 2) & 1) + 4 * (j5 >> 3) + (j5 & 3);
        const int sl = wide ? (128 * ((r >> 5) & 1) + 32 * (r >> 6) + ip) : (128 * (r >> 7) + ((r & 127) & ~31) + ip);
        const int kk = k0 + 8 * c;
        *(u32x4*)(WT + ((size_t)(T * 16 + (sl >> 4)) * (K >> 5) + (kk >> 5)) * 512 + (sl & 15) * 32 + (kk & 31)) = o; }
    asm volatile("s_waitcnt lgkmcnt(0)" ::: "memory");
}
__device__ __forceinline__ void xb_rows(const float* x, bf16_t* XL, bf16_t* XB, float* SS, int gw, int NGW, int lane) {
    for (int m = gw; m < M; m += 2 * NGW) {
        const int m2 = m + NGW;
        const f32x4* xr = (const f32x4*)(x + (size_t)m * D) + lane; const f32x4* xr2 = (const f32x4*)(x + (size_t)m2 * D) + lane;
        f32x4 v[4], v2[4]; float s = 0.f, s2 = 0.f;
#pragma unroll
        for (int j = 0; j < 4; ++j) { v[j] = __builtin_nontemporal_load(xr + 64 * j); v2[j] = __builtin_nontemporal_load(xr2 + 64 * j); }
#pragma unroll
        for (int j = 0; j < 4; ++j) { s += (v[j].x * v[j].x + v[j].y * v[j].y) + (v[j].z * v[j].z + v[j].w * v[j].w); s2 += (v2[j].x * v2[j].x + v2[j].y * v2[j].y) + (v2[j].z * v2[j].z + v2[j].w * v2[j].w); }
        s = wave_sum(s); s2 = wave_sum(s2);
        bf16_t* o8 = XB + xt_off(m, 4 * lane); bf16_t* o82 = XB + xt_off(m2, 4 * lane);
        bf16_t* l8 = XL + xt_off(m, 4 * lane); bf16_t* l82 = XL + xt_off(m2, 4 * lane);
#pragma unroll
        for (int j = 0; j < 4; ++j) {
            u32x2 w; w.x = cvtpk(v[j].x, v[j].y); w.y = cvtpk(v[j].z, v[j].w); *(u32x2*)(o8 + j * 8 * 512) = w;
            u32x2 l; l.x = cvtpk(v[j].x - bf_lo(w.x), v[j].y - bf_hi(w.x)); l.y = cvtpk(v[j].z - bf_lo(w.y), v[j].w - bf_hi(w.y)); *(u32x2*)(l8 + j * 8 * 512) = l;
            u32x2 w2; w2.x = cvtpk(v2[j].x, v2[j].y); w2.y = cvtpk(v2[j].z, v2[j].w); *(u32x2*)(o82 + j * 8 * 512) = w2;
            u32x2 l2; l2.x = cvtpk(v2[j].x - bf_lo(w2.x), v2[j].y - bf_hi(w2.x)); l2.y = cvtpk(v2[j].z - bf_lo(w2.y), v2[j].w - bf_hi(w2.y)); *(u32x2*)(l82 + j * 8 * 512) = l2; }
        if (lane < 16) { SS[(size_t)m * 16 + lane] = (lane == 0) ? s : 0.f; SS[(size_t)m2 * 16 + lane] = (lane == 0) ? s2 : 0.f; }
    }
}

__device__ __forceinline__ int crow(int r, int hi) { return (r & 3) + 8 * (r >> 2) + 4 * hi; }
constexpr int KS_STRIDE = 144, VT_STRIDE = 528, KS_BYTES = 256 * KS_STRIDE, VT_BYTES = 64 * VT_STRIDE;
static_assert(KS_BYTES + VT_BYTES + 16 * 128 * 4 <= RING_BYTES, "attention LDS");
__device__ __forceinline__ void attn_phase(LAS unsigned char* lds, const bf16_t* QKV, bf16_t* O, bf16_t* XL, const float* bo, const float* qg, const float* kg, const float* sinks, const float* rel_bias, int vcu, int G, const int tid) {
    const int lane = tid & 63, wid = __builtin_amdgcn_readfirstlane(tid >> 6), r32 = lane & 31, hi = lane >> 5;
    LAS unsigned char* Ks = lds;
    LAS unsigned char* Vt = lds + KS_BYTES;
    LAS float* biasT = (LAS float*)(lds + KS_BYTES + VT_BYTES);
    for (int i = tid; i < 2048; i += 512) { const int h = i >> 7, d = i & 127; biasT[i] = rel_bias[(int)BUCKET[d] * 16 + h]; }
    const int dc = tid & 7;
    float kgv[8];
#pragma unroll
    for (int e = 0; e < 8; ++e) kgv[e] = kg[dc * 8 + e];
    for (int u = vcu; u < 1024; u += G) {
        const int hk = u & 1, nb = (u >> 1) & 63, b = u >> 7;
        const long row_blk = (long)b * SEQ + nb * 128;
#pragma unroll
        for (int i = 0; i < 4; ++i) {
            const int c = tid + 512 * i, key = c >> 3;
            const long row = row_blk - 128 + key;
            const bool ok = (nb > 0) || (key >= 128);
            u32x4 kraw = (u32x4){0u, 0u, 0u, 0u}, vraw = (u32x4){0u, 0u, 0u, 0u};
            if (ok) { const bf16_t* p = QKV + (size_t)row * NQKV + 1024 + hk * 64 + dc * 8; kraw = *(const u32x4*)p; vraw = *(const u32x4*)(p + 128); }
            float kf[8];
            kf[0] = bf_lo(kraw.x); kf[1] = bf_hi(kraw.x); kf[2] = bf_lo(kraw.y); kf[3] = bf_hi(kraw.y); kf[4] = bf_lo(kraw.z); kf[5] = bf_hi(kraw.z); kf[6] = bf_lo(kraw.w); kf[7] = bf_hi(kraw.w);
            float ss = 0.f;
#pragma unroll
            for (int e = 0; e < 8; ++e) ss += kf[e] * kf[e];
            ss += __shfl_xor(ss, 1); ss += __shfl_xor(ss, 2); ss += __shfl_xor(ss, 4);
            const float rstd = 1.0f / sqrtf(ss * (1.f / 64.f) + EPS);
#pragma unroll
            for (int e = 0; e < 8; ++e) kf[e] = kf[e] * rstd * kgv[e];
            u32x4 kw; kw.x = cvtpk(kf[0], kf[1]); kw.y = cvtpk(kf[2], kf[3]); kw.z = cvtpk(kf[4], kf[5]); kw.w = cvtpk(kf[6], kf[7]);
            *(LAS u32x4*)(Ks + key * KS_STRIDE + dc * 16) = kw;
            LAS unsigned char* vp = Vt + (dc * 8) * VT_STRIDE + key * 2;
            *(LAS unsigned short*)(vp + 0 * VT_STRIDE) = (unsigned short)(vraw.x & 0xffffu); *(LAS unsigned short*)(vp + 1 * VT_STRIDE) = (unsigned short)(vraw.x >> 16);
            *(LAS unsigned short*)(vp + 2 * VT_STRIDE) = (unsigned short)(vraw.y & 0xffffu); *(LAS unsigned short*)(vp + 3 * VT_STRIDE) = (unsigned short)(vraw.y >> 16);
            *(LAS unsigned short*)(vp + 4 * VT_STRIDE) = (unsigned short)(vraw.z & 0xffffu); *(LAS unsigned short*)(vp + 5 * VT_STRIDE) = (unsigned short)(vraw.z >> 16);
            *(LAS unsigned short*)(vp + 6 * VT_STRIDE) = (unsigned short)(vraw.w & 0xffffu); *(LAS unsigned short*)(vp + 7 * VT_STRIDE) = (unsigned short)(vraw.w >> 16);
        }
        if (hk == 0) {
#pragma unroll 4
            for (int i = 0; i < 32; ++i) { const int idx = tid + 512 * i, r = idx >> 7, c8 = idx & 127;
                u32x4* lp = (u32x4*)(XL + xt_off((int)row_blk + r, 8 * c8)); const u32x4 lv = *lp; const f32x4 b0 = *((const f32x4*)bo + 2 * c8), b1 = *((const f32x4*)bo + 2 * c8 + 1); u32x4 ln;
                ln.x = cvtpk(bf_lo(lv.x) + b0.x, bf_hi(lv.x) + b0.y); ln.y = cvtpk(bf_lo(lv.y) + b0.z, bf_hi(lv.y) + b0.w);
                ln.z = cvtpk(bf_lo(lv.z) + b1.x, bf_hi(lv.z) + b1.y); ln.w = cvtpk(bf_lo(lv.w) + b1.z, bf_hi(lv.w) + b1.w);
                *lp = ln; }
        }
        __syncthreads();
        const int head = hk * 8 + wid;
        const float sink = sinks[head];
        const LAS float* bT = biasT + head * 128;
        for (int sb = 0; sb < 4; ++sb) {
            const long qrow = row_blk + sb * 32 + r32;
            const bf16_t* qp = QKV + (size_t)qrow * NQKV + head * 64 + hi * 8;
            u32x4 qraw[4];
#pragma unroll
            for (int ds = 0; ds < 4; ++ds) qraw[ds] = *(const u32x4*)(qp + ds * 16);
            float ss = 0.f;
#pragma unroll
            for (int ds = 0; ds < 4; ++ds) {
                const float a0 = bf_lo(qraw[ds].x), a1 = bf_hi(qraw[ds].x), a2 = bf_lo(qraw[ds].y), a3 = bf_hi(qraw[ds].y), a4 = bf_lo(qraw[ds].z), a5 = bf_hi(qraw[ds].z), a6 = bf_lo(qraw[ds].w), a7 = bf_hi(qraw[ds].w);
                ss += (a0 * a0 + a1 * a1) + (a2 * a2 + a3 * a3) + (a4 * a4 + a5 * a5) + (a6 * a6 + a7 * a7);
            }
            ss += __shfl_xor(ss, 32);
            const float qs = 0.125f / sqrtf(ss * (1.f / 64.f) + EPS);
            bf16x8 qf[4];
#pragma unroll
            for (int ds = 0; ds < 4; ++ds) {
                const f32x4 g0 = *(const f32x4*)(qg + ds * 16 + hi * 8), g1 = *(const f32x4*)(qg + ds * 16 + hi * 8 + 4);
                u32x4 w;
                w.x = cvtpk(bf_lo(qraw[ds].x) * qs * g0.x, bf_hi(qraw[ds].x) * qs * g0.y); w.y = cvtpk(bf_lo(qraw[ds].y) * qs * g0.z, bf_hi(qraw[ds].y) * qs * g0.w);
                w.z = cvtpk(bf_lo(qraw[ds].z) * qs * g1.x, bf_hi(qraw[ds].z) * qs * g1.y); w.w = cvtpk(bf_lo(qraw[ds].w) * qs * g1.z, bf_hi(qraw[ds].w) * qs * g1.w);
                qf[ds] = __builtin_bit_cast(bf16x8, w);
            }
            f32x16 S[5];
#pragma unroll
            for (int j = 0; j < 5; ++j) {
                f32x16 a = {};
#pragma unroll
                for (int ds = 0; ds < 4; ++ds) {
                    const bf16x8 kfr = *(const LAS bf16x8*)(Ks + (32 * (sb + j) + r32) * KS_STRIDE + ds * 32 + hi * 16);
                    a = __builtin_amdgcn_mfma_f32_32x32x16_bf16(kfr, qf[ds], a, 0, 0, 0);
                }
                S[j] = a;
            }
            const int qi = sb * 32 + r32;
            float mx = sink;
#pragma unroll
            for (int j = 0; j < 5; ++j)
#pragma unroll
                for (int i = 0; i < 16; ++i) {
                    const int ki = 32 * (sb + j) + crow(i, hi), dist = qi + 128 - ki;
                    const bool valid = (dist >= 0) && (dist < 128) && ((nb > 0) || (ki >= 128));
                    const float s = valid ? S[j][i] + bT[dist & 127] : -INFINITY;
                    S[j][i] = s; mx = fmaxf(mx, s);
                }
            mx = fmaxf(mx, __shfl_xor(mx, 32));
            float l = 0.f;
#pragma unroll
            for (int j = 0; j < 5; ++j)
#pragma unroll
                for (int i = 0; i < 16; ++i) { const float p = __expf(S[j][i] - mx); S[j][i] = p; l += p; }
            l += __shfl_xor(l, 32);
            l += __expf(sink - mx);
            f32x16 o0 = {}, o1 = {};
#pragma unroll
            for (int j = 0; j < 5; ++j)
#pragma unroll
                for (int s = 0; s < 2; ++s) {
                    u32x4 pw; pw.x = cvtpk(S[j][8 * s + 0], S[j][8 * s + 1]); pw.y = cvtpk(S[j][8 * s + 2], S[j][8 * s + 3]); pw.z = cvtpk(S[j][8 * s + 4], S[j][8 * s + 5]); pw.w = cvtpk(S[j][8 * s + 6], S[j][8 * s + 7]);
                    const bf16x8 pf = __builtin_bit_cast(bf16x8, pw);
                    const int keyoff = 32 * (sb + j) + 16 * s + 4 * hi;
                    const LAS unsigned char* v0 = Vt + r32 * VT_STRIDE + keyoff * 2;
                    const LAS unsigned char* v1 = v0 + 32 * VT_STRIDE;
                    const s16x4 a0 = *(const LAS s16x4*)v0, a1 = *(const LAS s16x4*)(v0 + 16);
                    const s16x4 b0 = *(const LAS s16x4*)v1, b1 = *(const LAS s16x4*)(v1 + 16);
                    const bf16x8 vf0 = __builtin_shufflevector(a0, a1, 0, 1, 2, 3, 4, 5, 6, 7), vf1 = __builtin_shufflevector(b0, b1, 0, 1, 2, 3, 4, 5, 6, 7);
                    o0 = __builtin_amdgcn_mfma_f32_32x32x16_bf16(vf0, pf, o0, 0, 0, 0);
                    o1 = __builtin_amdgcn_mfma_f32_32x32x16_bf16(vf1, pf, o1, 0, 0, 0);
                }
            const float inv = 1.0f / l;
            bf16_t* op = O + (size_t)qrow * D + head * 64 + 4 * hi;
#pragma unroll
            for (int i4 = 0; i4 < 4; ++i4) {
                u32x2 w0, w1;
                w0.x = cvtpk(o0[4 * i4 + 0] * inv, o0[4 * i4 + 1] * inv); w0.y = cvtpk(o0[4 * i4 + 2] * inv, o0[4 * i4 + 3] * inv);
                w1.x = cvtpk(o1[4 * i4 + 0] * inv, o1[4 * i4 + 1] * inv); w1.y = cvtpk(o1[4 * i4 + 2] * inv, o1[4 * i4 + 3] * inv);
                *(u32x2*)(op + 8 * i4) = w0; *(u32x2*)(op + 32 + 8 * i4) = w1;
            }
        }
        __syncthreads();
    }
}

#define XB_TMO      128
#define XB_XCNT(j)  (256  + 64 * (j))
#define XB_XSUB(j)  (1280 + 64 * (j))
#define XB_XGEN(j)  (2304 + 64 * (j))
#define XB_TOP      3328
#define XB_TOPGEN   3392
#define XCD_BAR_WORDS 3456
#define XB_SPIN_CAP (1u << 18)
__device__ __forceinline__ unsigned xb_ld(unsigned* p)              { return __hip_atomic_load(p, __ATOMIC_RELAXED, __HIP_MEMORY_SCOPE_AGENT); }
__device__ __forceinline__ unsigned xb_add(unsigned* p, unsigned v) { return __hip_atomic_fetch_add(p, v, __ATOMIC_RELAXED, __HIP_MEMORY_SCOPE_AGENT); }
__device__ __forceinline__ unsigned xb_xcc_id() { return (unsigned)__builtin_amdgcn_s_getreg((3 << 11) | 20) & 0xFu; }
#define XB_SPIN(cond, bar) do { unsigned _sp = 0; while (cond) { __builtin_amdgcn_s_sleep(1); \
    if ((++_sp & 255u) == 0u) { if (xb_ld(&(bar)[XB_TMO])) break; if (_sp > XB_SPIN_CAP) { atomicAdd(&(bar)[XB_TMO], 1u); break; } } } } while (0)
struct XcdBarrier { unsigned* bar; unsigned x; volatile LAS unsigned* st; };
__device__ __forceinline__ XcdBarrier xcd_barrier_post(unsigned* bar, volatile LAS unsigned* st) {
    XcdBarrier b; b.bar = bar; b.x = xb_xcc_id(); b.st = st;
    if (threadIdx.x == 0) (void)xb_add(&bar[XB_XCNT(b.x)], 1u);
    return b;
}
__device__ __forceinline__ void xcd_barrier_complete(unsigned* bar, unsigned x, unsigned& nloc, unsigned& nx) {
    const unsigned G = gridDim.x * gridDim.y * gridDim.z;
    unsigned sum, cnt, mine, sp = 0u;
    for (;;) {
        sum = 0u; cnt = 0u; mine = 0u;
#pragma unroll
        for (unsigned j = 0; j < 16; ++j) { const unsigned c = xb_ld(&bar[XB_XCNT(j)]); sum += c; cnt += (c > 0u) ? 1u : 0u; mine = (j == x) ? c : mine; }
        if (sum == G) break;
        __builtin_amdgcn_s_sleep(1);
        if ((++sp & 255u) == 0u) { if (xb_ld(&bar[XB_TMO])) break; if (sp > XB_SPIN_CAP) { atomicAdd(&bar[XB_TMO], 1u); break; } }
    }
    nloc = mine > 0u ? mine : 1u; nx = cnt > 0u ? cnt : 1u;
}
__device__ __forceinline__ void xcd_barrier(const XcdBarrier& b) {
    asm volatile("s_waitcnt vmcnt(0)" ::: "memory");
    __syncthreads();
    if (threadIdx.x == 0) {
        unsigned* bar = b.bar;
        __builtin_amdgcn_s_waitcnt(0);
        unsigned nloc = b.st[0], nx = b.st[1];
        if (nloc == 0u) { xcd_barrier_complete(bar, b.x, nloc, nx); b.st[0] = nloc; b.st[1] = nx; }
        const unsigned old = xb_add(&bar[XB_XSUB(b.x)], 1u);
        const unsigned gen = old / nloc;
        if (old + 1u == (gen + 1u) * nloc) {
            __builtin_amdgcn_fence(__ATOMIC_RELEASE, "agent");
            asm volatile("s_waitcnt vmcnt(0)" ::: "memory");
            const unsigned og = xb_add(&bar[XB_TOP], 1u);
            const unsigned tg = og / nx;
            if (og + 1u == (tg + 1u) * nx) xb_add(&bar[XB_TOPGEN], 1u);
            else XB_SPIN(xb_ld(&bar[XB_TOPGEN]) == tg, bar);
            __builtin_amdgcn_fence(__ATOMIC_ACQUIRE, "agent");
            xb_add(&bar[XB_XGEN(b.x)], 1u);
            asm volatile("s_waitcnt vmcnt(0)" ::: "memory");
        } else {
            XB_SPIN(xb_ld(&bar[XB_XGEN(b.x)]) == gen, bar);
            __builtin_amdgcn_fence(__ATOMIC_ACQUIRE, "agent");
            asm volatile("s_waitcnt vmcnt(0)" ::: "memory");
        }
    }
    __syncthreads();
}

struct Args { const float* in[22]; float* out; unsigned char* ws; int lo, hi; };
static_assert(sizeof(Args) == 22 * 8 + 8 + 8 + 8, "Args has no padding");

__global__ void __launch_bounds__(512, 2) mk_fwd(Args args) {
    extern __shared__ __attribute__((aligned(16))) unsigned char lds_raw[];
    LAS unsigned char* lds = (LAS unsigned char*)lds_raw;
    cg::grid_group grid = cg::this_grid();
    const int G = gridDim.x, bx = blockIdx.x;
    const int vcu = (G % 8 == 0) ? (bx % 8) * (G / 8) + bx / 8 : bx;
    const int NGW = G * 8;
    volatile LAS unsigned* MISC = (volatile LAS unsigned*)(lds + RING_BYTES + 1024);
    if (threadIdx.x == 0) { MISC[0] = 0u; MISC[1] = 0u; }
    __syncthreads();
    const bool one_launch = (args.hi - args.lo) > 1;
    XcdBarrier bar; bar.bar = (unsigned*)args.ws; bar.x = 0; bar.st = MISC;
    if (one_launch) bar = xcd_barrier_post((unsigned*)args.ws, MISC);

    for (int step = args.lo; step < args.hi; ++step) {
        int tid = threadIdx.x; asm volatile("" : "+v"(tid) :: "memory");
        const int lane = tid & 63, wave = __builtin_amdgcn_readfirstlane(tid >> 6), gw = vcu * 8 + wave;
        const int op = PROG[step][0], L = PROG[step][1], F = PROG[step][2];
        size_t zoff = 0; asm volatile("" : "+s"(zoff));
        unsigned char* ws = args.ws + zoff;
        float* xout = args.out + zoff;
        bf16_t* XL = (bf16_t*)(ws + WS_XL);
        bf16_t* XB = (bf16_t*)(ws + WS_H);
        float* SS = (float*)(ws + WS_SS);
        bf16_t* ACT = (bf16_t*)(ws + WS_ACT);
        bf16_t* WIN = (bf16_t*)(ws + WS_WIN);
        bf16_t* WOUT = (bf16_t*)(ws + WS_WOUT);
        bf16_t* CIN = (bf16_t*)(ws + WS_CIN);
        bf16_t* COUT = (bf16_t*)(ws + WS_COUT);
        bf16_t* POOLW = (bf16_t*)(ws + WS_POOL);
        bf16_t* WQKV = (bf16_t*)(ws + WS_WQKV);
        bf16_t* WO = (bf16_t*)(ws + WS_WO);
        bf16_t* CONV_U = ACT + (size_t)2 * M * D;
        bf16_t* ATT_O = ACT + (size_t)M * NQKV;

        if (op == OP_PROLOGUE) {
            LAS float* scr = (LAS float*)(lds + wave * 16384);
            constexpr int I_FI = (D / 64) * (2 * FF / 32), I_FO = (FF / 64) * (D / 32), I_CI = (D / 64) * (3 * D / 32), I_CO = (D / 64) * (D / 32), I_P = (256 / 64) * (256 / 32), I_Q = (D / 64) * (NQKV / 32);
            constexpr int NITEMS = 8 * I_FI + 8 * I_FO + 2 * I_CI + 2 * I_CO + 4 * I_P + I_Q + I_CO;
            for (int it = gw; it < NITEMS; it += NGW) {
                int r = it;
                if (r < 8 * I_FI) { const int idx = r / I_FI; r %= I_FI; const int l = idx >> 1, f = idx & 1;
                    transpose_item(args.in[f ? 6 : 2] + (size_t)l * WIN_STRIDE, D, 2 * FF, WIN + (size_t)idx * WIN_STRIDE, 1, args.in[f ? 5 : 1] + l * D, nullptr, 1.0f, scr, r, lane); continue; }
                r -= 8 * I_FI;
                if (r < 8 * I_FO) { const int idx = r / I_FO; r %= I_FO; const int l = idx >> 1, f = idx & 1;
                    transpose_item(args.in[f ? 7 : 3] + (size_t)l * WOUT_STRIDE, FF, D, WOUT + (size_t)idx * WOUT_STRIDE, 16, nullptr, nullptr, 0.5f, scr, r, lane); continue; }
                r -= 8 * I_FO;
                if (r < 2 * I_CI) { const int j = r / I_CI; r %= I_CI;
                    transpose_item(args.in[8] + (size_t)j * D * 3 * D, D, 3 * D, CIN + (size_t)j * 3 * D * D, 2, args.in[4] + (j ? 3 : 0) * D, nullptr, 1.0f, scr, r, lane); continue; }
                r -= 2 * I_CI;
                if (r < 2 * I_CO) { const int j = r / I_CO; r %= I_CO;
                    transpose_item(args.in[10] + (size_t)j * D * D, D, D, COUT + (size_t)j * D * D, 16, nullptr, nullptr, 1.0f, scr, r, lane); continue; }
                r -= 2 * I_CO;
                if (r < 4 * I_P) { const int gidx = r / I_P; r %= I_P;
                    transpose_item(args.in[11] + (size_t)gidx * 256 * 256, 256, 256, POOLW + (size_t)gidx * 256 * 256, 16, args.in[4] + 1 * D + gidx * 256, args.in[13] + gidx * 256, 1.0f, scr, r, lane); continue; }
                r -= 4 * I_P;
                if (r < I_Q) { transpose_item(args.in[14], D, NQKV, WQKV, 0, args.in[4] + 2 * D, nullptr, 1.0f, scr, r, lane); continue; }
                r -= I_Q;
                transpose_item(args.in[19], D, D, WO, 16, nullptr, nullptr, 1.0f, scr, r, lane);
            }
            if (gw == 0) { for (int i = lane; i < D; i += 64) ((float*)(ws + WS_PBIAS))[i] = args.in[12][i] * args.in[13][i]; }
            xb_rows(args.in[0], XL, XB, SS, gw, NGW, lane);
        } else if (op == OP_SWIGLU) {
            pg8::Gemm g{XB, WIN + (size_t)(L * 2 + F) * WIN_STRIDE, M, 2 * FF, D, D, 0, 1};
            pg8::StaticOrder S; S.init(M, 2 * FF, G, bx);
            pg8::EpiSwiglu E{ACT, FF, SS};
            pg8::gemm_phase<pg8::EpiSwiglu>(lds, g, S, E, tid);
        } else if (op == OP_RESID_FFN || op == OP_CONV_OUT || op == OP_POOL_GEMM || op == OP_WO) {
            const bf16_t* gA = ACT; const bf16_t* gB = POOLW; int gK = 256, glda = D, gpn = 256;
            if (op == OP_RESID_FFN) { gB = WOUT + (size_t)(L * 2 + F) * WOUT_STRIDE; gK = FF; glda = FF; gpn = 0; }
            else if (op == OP_CONV_OUT) { gA = CONV_U; gB = COUT + (size_t)F * D * D; gK = D; gpn = 0; }
            else if (op == OP_WO) { gA = ATT_O; gB = WO; gK = D; gpn = 0; }
            const pg8::Gemm g{gA, gB, M, D, gK, glda, gpn, (op == OP_RESID_FFN) ? 1 : 0};
            pg8::StaticOrder S; S.init(M, D, G, bx);
            if (step == NSTEPS - 1) { const pg8::EpiResid<true> E{xout, XB, XL, SS}; pg8::gemm_phase<pg8::EpiResid<true>>(lds, g, S, E, tid); }
            else { const pg8::EpiResid<false> E{nullptr, XB, XL, SS}; pg8::gemm_phase<pg8::EpiResid<false>>(lds, g, S, E, tid); }
        } else if (op == OP_CONV_IN) {
            pg8::Gemm g{XB, CIN + (size_t)F * 3 * D * D, M, 3 * D, D, D, 0, 1};
            pg8::StaticOrder S; S.init(M, 3 * D, G, bx);
            pg8::EpiConvIn E{ACT, ACT + (size_t)M * D, SS};
            pg8::gemm_phase<pg8::EpiConvIn>(lds, g, S, E, tid);
        } else if (op == OP_CONV_EW) {
            const bf16_t* Bb = ACT; const bf16_t* Z = ACT + (size_t)M * D; const float* cw = args.in[9] + (size_t)F * 3 * D;
            const int ch = tid & 127, rsub = tid >> 7;
            const f32x4 w0a = *(const f32x4*)(cw + ch * 8), w0b = *(const f32x4*)(cw + ch * 8 + 4);
            const f32x4 w1a = *(const f32x4*)(cw + D + ch * 8), w1b = *(const f32x4*)(cw + D + ch * 8 + 4);
            const f32x4 w2a = *(const f32x4*)(cw + 2 * D + ch * 8), w2b = *(const f32x4*)(cw + 2 * D + ch * 8 + 4);
            for (int grp = vcu; grp < M / 16; grp += G) {
                u32x4 z0[4], z1[4], z2[4], bb[4];
#pragma unroll
                for (int k = 0; k < 4; ++k) {
                    const int row = grp * 16 + k * 4 + rsub, t = row & (SEQ - 1);
                    const size_t off = (size_t)row * D + ch * 8;
                    z0[k] = *(const u32x4*)(Z + off);
                    z1[k] = (t >= 1) ? *(const u32x4*)(Z + off - D) : (u32x4){0u, 0u, 0u, 0u};
                    z2[k] = (t >= 2) ? *(const u32x4*)(Z + off - 2 * D) : (u32x4){0u, 0u, 0u, 0u};
                    bb[k] = *(const u32x4*)(Bb + off);
                }
#pragma unroll
                for (int k = 0; k < 4; ++k) {
                    const int row = grp * 16 + k * 4 + rsub;
                    const size_t off = (size_t)row * D + ch * 8;
                    float r[8];
#define CONV1(q, zz0, zz1, zz2, bbb, wa0, wa1, wa2) r[q] = (bbb) * ((wa0) * (zz2) + (wa1) * (zz1) + (wa2) * (zz0))
                    CONV1(0, bf_lo(z0[k].x), bf_lo(z1[k].x), bf_lo(z2[k].x), bf_lo(bb[k].x), w0a.x, w1a.x, w2a.x);
                    CONV1(1, bf_hi(z0[k].x), bf_hi(z1[k].x), bf_hi(z2[k].x), bf_hi(bb[k].x), w0a.y, w1a.y, w2a.y);
                    CONV1(2, bf_lo(z0[k].y), bf_lo(z1[k].y), bf_lo(z2[k].y), bf_lo(bb[k].y), w0a.z, w1a.z, w2a.z);
                    CONV1(3, bf_hi(z0[k].y), bf_hi(z1[k].y), bf_hi(z2[k].y), bf_hi(bb[k].y), w0a.w, w1a.w, w2a.w);
                    CONV1(4, bf_lo(z0[k].z), bf_lo(z1[k].z), bf_lo(z2[k].z), bf_lo(bb[k].z), w0b.x, w1b.x, w2b.x);
                    CONV1(5, bf_hi(z0[k].z), bf_hi(z1[k].z), bf_hi(z2[k].z), bf_hi(bb[k].z), w0b.y, w1b.y, w2b.y);
                    CONV1(6, bf_lo(z0[k].w), bf_lo(z1[k].w), bf_lo(z2[k].w), bf_lo(bb[k].w), w0b.z, w1b.z, w2b.z);
                    CONV1(7, bf_hi(z0[k].w), bf_hi(z1[k].w), bf_hi(z2[k].w), bf_hi(bb[k].w), w0b.w, w1b.w, w2b.w);
#undef CONV1
                    u32x4 w; w.x = cvtpk(r[0], r[1]); w.y = cvtpk(r[2], r[3]); w.z = cvtpk(r[4], r[5]); w.w = cvtpk(r[6], r[7]);
                    *(u32x4*)(CONV_U + off) = w;
                }
            }
        } else if (op == OP_POOL_DIFF) {
            LAS float* rsl = (LAS float*)lds;
            const float* pbias = (const float*)(ws + WS_PBIAS);
            for (int blk = vcu; blk < M / 64; blk += G) {
                const int row0 = blk * 64, t0 = row0 & (SEQ - 1);
                if (tid < 79) rsl[tid] = (t0 - 15 + tid >= 0) ? pg8::row_rstd(SS, row0 - 15 + tid) : 0.f;
                __syncthreads();
#define POOL_LOAD(X, IT) \
                    const int rl##X = ((tid + 512 * (IT)) >> 7), t##X = t0 + rl##X, cnt##X = (t##X + 1 < win) ? (t##X + 1) : win; \
                    const size_t off##X = (size_t)(row0 + rl##X) * D + ch * 8; \
                    const u32x4 h0##X = *(const u32x4*)(XB + xt_off(row0 + rl##X, ch * 8)); \
                    u32x4* lp##X = (u32x4*)(XL + xt_off(row0 + rl##X, ch * 8)); const u32x4 lv##X = *lp##X; \
                    u32x4 hv##X[15]; \
                    _Pragma("unroll") for (int i = 1; i < 16; ++i) hv##X[i - 1] = (i < cnt##X) ? *(const u32x4*)(XB + xt_off(row0 + rl##X - i, ch * 8)) : (u32x4){0u, 0u, 0u, 0u};
#define POOL_FINISH(X) { \
                    const float r0 = rsl[15 + rl##X]; float s[8], c0[8]; \
                    c0[0] = bf_lo(h0##X.x) * r0; c0[1] = bf_hi(h0##X.x) * r0; c0[2] = bf_lo(h0##X.y) * r0; c0[3] = bf_hi(h0##X.y) * r0; c0[4] = bf_lo(h0##X.z) * r0; c0[5] = bf_hi(h0##X.z) * r0; c0[6] = bf_lo(h0##X.w) * r0; c0[7] = bf_hi(h0##X.w) * r0; \
                    _Pragma("unroll") for (int e = 0; e < 8; ++e) s[e] = c0[e]; \
                    _Pragma("unroll") for (int i = 1; i < 16; ++i) { const float ri = (i < cnt##X) ? rsl[15 + rl##X - i] : 0.f; \
                        s[0] += bf_lo(hv##X[i - 1].x) * ri; s[1] += bf_hi(hv##X[i - 1].x) * ri; s[2] += bf_lo(hv##X[i - 1].y) * ri; s[3] += bf_hi(hv##X[i - 1].y) * ri; \
                        s[4] += bf_lo(hv##X[i - 1].z) * ri; s[5] += bf_hi(hv##X[i - 1].z) * ri; s[6] += bf_lo(hv##X[i - 1].w) * ri; s[7] += bf_hi(hv##X[i - 1].w) * ri; } \
                    const float ic = 1.0f / (float)cnt##X; \
                    u32x4 w; w.x = cvtpk(s[0] * ic - c0[0], s[1] * ic - c0[1]); w.y = cvtpk(s[2] * ic - c0[2], s[3] * ic - c0[3]); \
                    w.z = cvtpk(s[4] * ic - c0[4], s[5] * ic - c0[5]); w.w = cvtpk(s[6] * ic - c0[6], s[7] * ic - c0[7]); \
                    *(u32x4*)(ACT + off##X) = w; \
                    u32x4 ln;   \
                    ln.x = cvtpk(bf_lo(lv##X.x) + pb0.x, bf_hi(lv##X.x) + pb0.y); ln.y = cvtpk(bf_lo(lv##X.y) + pb0.z, bf_hi(lv##X.y) + pb0.w); \
                    ln.z = cvtpk(bf_lo(lv##X.z) + pb1.x, bf_hi(lv##X.z) + pb1.y); ln.w = cvtpk(bf_lo(lv##X.w) + pb1.z, bf_hi(lv##X.w) + pb1.w); \
                    *lp##X = ln; }
                const int ch = tid & 127, win = 2 << (ch >> 5);
                const f32x4 pb0 = *(const f32x4*)(pbias + ch * 8), pb1 = *(const f32x4*)(pbias + ch * 8 + 4);
#pragma unroll 1
                for (int it = 0; it < 16; it += 2) {
                    POOL_LOAD(A, it)
                    POOL_LOAD(B, it + 1)
                    POOL_FINISH(A)
                    POOL_FINISH(B)
                }
#undef POOL_LOAD
#undef POOL_FINISH
                __syncthreads();
            }
        } else if (op == OP_QKV) {
            pg8::Gemm g{XB, WQKV, M, NQKV, D, D, 0, 1};
            pg8::StaticOrder S; S.init(M, NQKV, G, bx);
            pg8::EpiBf16 E{ACT, NQKV, args.in[15], SS};
            pg8::gemm_phase<pg8::EpiBf16>(lds, g, S, E, tid);
        } else if (op == OP_ATTN) {
            attn_phase(lds, ACT, ATT_O, XL, args.in[20], args.in[16], args.in[17], args.in[18], args.in[21], vcu, G, tid);
        }
        if (step + 1 < args.hi) { if (step == args.lo) grid.sync(); else xcd_barrier(bar); }
    }
}

extern "C" void kernel_launch(void* const* d_in, const int* in_sizes, int n_in, void* d_out, int out_size, void* d_ws, size_t ws_size, hipStream_t stream) {
    static int grid = 0;
    if (grid == 0) {
        if (n_in != 22 || out_size != M * D || ws_size < WS_END) { fprintf(stderr, "kernel_launch: unexpected shapes n_in %d out %d ws %zu\n", n_in, out_size, ws_size); grid = -1; return; }
        int dev = 0, cus = 0, per_cu = 0;
        if (hipGetDevice(&dev) != hipSuccess || hipDeviceGetAttribute(&cus, hipDeviceAttributeMultiprocessorCount, dev) != hipSuccess) { grid = -1; return; }
        if (hipFuncSetAttribute((const void*)mk_fwd, hipFuncAttributeMaxDynamicSharedMemorySize, LDS_BYTES) != hipSuccess) { fprintf(stderr, "kernel_launch: hipFuncSetAttribute failed\n"); grid = -1; return; }
        if (hipOccupancyMaxActiveBlocksPerMultiprocessor(&per_cu, (const void*)mk_fwd, 512, LDS_BYTES) != hipSuccess || per_cu < 1) { fprintf(stderr, "kernel_launch: occupancy query says %d\n", per_cu); per_cu = 1; }
        (void)hipGetLastError();
        grid = cus * per_cu;
    }
    if (grid < 0) return;
    Args a{};
    for (int i = 0; i < 22; ++i) a.in[i] = (const float*)d_in[i];
    a.out = (float*)d_out; a.ws = (unsigned char*)d_ws;
#if MK_ONE_LAUNCH
    if (hipMemsetAsync(d_ws, 0, CTL_BYTES, stream) != hipSuccess) { fprintf(stderr, "kernel_launch: memset of control words failed\n"); return; }
    a.lo = 0; a.hi = NSTEPS;
    void* kargs[] = {&a};
    hipError_t e = hipLaunchCooperativeKernel((const void*)mk_fwd, dim3(grid), dim3(512), kargs, LDS_BYTES, stream);
    if (e != hipSuccess) fprintf(stderr, "cooperative launch failed: %s (grid %d)\n", hipGetErrorString(e), grid);
#else
    for (int s = 0; s < NSTEPS; ++s) {
        a.lo = s; a.hi = s + 1;
        hipLaunchKernelGGL(mk_fwd, dim3(grid), dim3(512), LDS_BYTES, stream, a);
    }
#endif
}
```
